# Optimizing an MI355X kernel written in HIP

```python
import jax, jax.numpy as jnp
from jax import lax
import numpy as np

D_MODEL = 1024
BATCH = 8
SEQ = 4096
DEPTH = 2

CTX_LEN = 256
GRID_W = 64
HEAD_DIM = 64
NA_HEADS = 6
NA_KR = 8
NA_KW = 16
NA_QB = 16
NA_SPAN = NA_QB + NA_KW
SWA_HEADS = 6
SWA_KV_HEADS = 2
SWA_WINDOW = 128
SWA_BLOCK = 128
FNET_GROUPS = 4
FNET_GROUP_DIM = 64
NA_WIDTH = NA_HEADS * HEAD_DIM
SWA_WIDTH = SWA_HEADS * HEAD_DIM
SWA_KV_WIDTH = SWA_KV_HEADS * HEAD_DIM
FNET_WIDTH = FNET_GROUPS * FNET_GROUP_DIM
D_MIX = NA_WIDTH + SWA_WIDTH + FNET_WIDTH
D_IN = 3 * NA_WIDTH + SWA_WIDTH + 2 * SWA_KV_WIDTH + FNET_WIDTH
IN_SPLITS = (NA_WIDTH, 2 * NA_WIDTH, 3 * NA_WIDTH, 3 * NA_WIDTH + SWA_WIDTH,
             3 * NA_WIDTH + SWA_WIDTH + SWA_KV_WIDTH, 3 * NA_WIDTH + SWA_WIDTH + 2 * SWA_KV_WIDTH)
D_FF = 256 * ((8 * D_MODEL // 3 + 255) // 256)
N_SUB = 3
N_MOD = 3 * N_SUB
MACARON_WEIGHT = 0.5
ROPE_BASE = 10000.0
RMS_EPS = 1e-6
NEG_INF = -1e30

kernel_name = 'hybrid_natten_swa_fnet_macaron_dit'


def rms_norm(x, g):
    x32 = x.astype(jnp.float32)
    y = x32 * lax.rsqrt(jnp.mean(x32 * x32, axis=-1, keepdims=True) + RMS_EPS)
    return (y * g.astype(jnp.float32)).astype(x.dtype)


def modulate(h, shift, scale):
    return h * (1 + scale) + shift


def swiglu(h, w1, w2):
    gate, up = jnp.split(h @ w1, 2, axis=-1)
    return (jax.nn.silu(gate) * up) @ w2


def rope_half(x, pos):
    half = x.shape[-1] // 2
    inv = ROPE_BASE ** (-jnp.arange(half, dtype=jnp.float32) / half)
    ang = pos[:, None] * inv[None, :]
    cos = jnp.cos(ang)[:, None, :]
    sin = jnp.sin(ang)[:, None, :]
    x1, x2 = x[..., :half], x[..., half:]
    return jnp.concatenate([x1 * cos - x2 * sin, x1 * sin + x2 * cos], axis=-1)


def axial_rope(x):
    s = x.shape[1]
    t = jnp.arange(s)
    rows = (t // GRID_W).astype(jnp.float32)
    cols = (t % GRID_W).astype(jnp.float32)
    x32 = x.astype(jnp.float32)
    a = x.shape[-1] // 2
    out = jnp.concatenate([rope_half(x32[..., :a], rows), rope_half(x32[..., a:], cols)], axis=-1)
    return out.astype(x.dtype)


def _na_column_tables():
    n_jb = GRID_W // NA_QB
    k_start = np.clip(np.arange(n_jb) * NA_QB - NA_KW // 2, 0, GRID_W - NA_SPAN)
    col_idx = k_start[:, None] + np.arange(NA_SPAN)[None, :]
    q_col = np.arange(n_jb)[:, None] * NA_QB + np.arange(NA_QB)[None, :]
    w_start = np.clip(q_col - NA_KW // 2, 0, GRID_W - NA_KW)[..., None]
    k_col = col_idx[:, None, :]
    valid = (k_col >= w_start) & (k_col < w_start + NA_KW)
    offset = np.clip(k_col - q_col[..., None] + NA_KW - 1, 0, 2 * NA_KW - 2)
    return col_idx, valid, offset


def neighbourhood_attention(q, k, v, kc, vc, rpb):
    b, s, h, hd = q.shape
    rows = s // GRID_W
    kr = min(NA_KR, rows)
    n_jb = GRID_W // NA_QB
    n_lat = kr * NA_SPAN
    scale = hd ** -0.5
    col_idx, col_valid, col_off = _na_column_tables()
    qg = q.reshape(b, rows, n_jb, NA_QB, h, hd)
    kg = k.reshape(b, rows, GRID_W, h, hd)[:, :, col_idx]
    vg = v.reshape(b, rows, GRID_W, h, hd)[:, :, col_idx]
    rpb_col = rpb[:, :, col_off]
    valid = jnp.asarray(col_valid)[None, None, :, :, None, :]

    def row_step(r):
        rs = jnp.clip(r - kr // 2, 0, rows - kr)
        q_r = lax.dynamic_index_in_dim(qg, r, axis=1, keepdims=False)
        k_r = lax.dynamic_slice_in_dim(kg, rs, kr, axis=1)
        v_r = lax.dynamic_slice_in_dim(vg, rs, kr, axis=1)
        row_off = rs + jnp.arange(kr) - r + NA_KR - 1
        bias = jnp.transpose(rpb_col[:, row_off], (0, 2, 3, 1, 4)).astype(jnp.float32)
        s_lat = jnp.einsum('bjqhd,bijshd->bhjqis', q_r, k_r).astype(jnp.float32) * scale + bias
        s_lat = jnp.where(valid, s_lat, NEG_INF).reshape(b, h, n_jb, NA_QB, n_lat)
        s_ctx = jnp.einsum('bjqhd,blhd->bhjql', q_r, kc).astype(jnp.float32) * scale
        p = jax.nn.softmax(jnp.concatenate([s_lat, s_ctx], axis=-1), axis=-1).astype(v.dtype)
        p_lat = p[..., :n_lat].reshape(b, h, n_jb, NA_QB, kr, NA_SPAN)
        p_ctx = p[..., n_lat:]
        return (jnp.einsum('bhjqis,bijshd->bjqhd', p_lat, v_r)
                + jnp.einsum('bhjql,blhd->bjqhd', p_ctx, vc))

    out = lax.map(row_step, jnp.arange(rows))
    return jnp.moveaxis(out, 0, 1).reshape(b, s, h * hd)


def window_gqa_attention(q, k, v, kc, vc, sink):
    b, s, h, hd = q.shape
    kvh = k.shape[2]
    g = h // kvh
    n_ctx = kc.shape[1]
    nb = s // SWA_BLOCK
    span = 3 * SWA_BLOCK
    scale = hd ** -0.5
    qb = q.reshape(b, nb, SWA_BLOCK, kvh, g, hd)
    pad = ((0, 0), (SWA_BLOCK, SWA_BLOCK), (0, 0), (0, 0))
    kp = jnp.pad(k, pad)
    vp = jnp.pad(v, pad)
    rel = jnp.arange(span)[None, :] - SWA_BLOCK - jnp.arange(SWA_BLOCK)[:, None]
    in_window = jnp.abs(rel) <= SWA_WINDOW
    sink_l = jnp.broadcast_to(sink.astype(jnp.float32).reshape(1, kvh, g, 1, 1), (b, kvh, g, SWA_BLOCK, 1))

    def block_step(n):
        q_n = lax.dynamic_index_in_dim(qb, n, axis=1, keepdims=False)
        k_n = lax.dynamic_slice_in_dim(kp, n * SWA_BLOCK, span, axis=1)
        v_n = lax.dynamic_slice_in_dim(vp, n * SWA_BLOCK, span, axis=1)
        kpos = (n - 1) * SWA_BLOCK + jnp.arange(span)
        valid = in_window & ((kpos >= 0) & (kpos < s))[None, :]
        s_lat = jnp.einsum('bqkgd,bskd->bkgqs', q_n, k_n).astype(jnp.float32) * scale
        s_lat = jnp.where(valid, s_lat, NEG_INF)
        s_ctx = jnp.einsum('bqkgd,blkd->bkgql', q_n, kc).astype(jnp.float32) * scale
        p = jax.nn.softmax(jnp.concatenate([s_lat, s_ctx, sink_l], axis=-1), axis=-1).astype(v.dtype)
        return (jnp.einsum('bkgqs,bskd->bqkgd', p[..., :span], v_n)
                + jnp.einsum('bkgql,blkd->bqkgd', p[..., span:span + n_ctx], vc))

    out = lax.map(block_step, jnp.arange(nb))
    return jnp.moveaxis(out, 0, 1).reshape(b, s, h * hd)


def context_attention(qc, kc, vc, sink=None):
    b, l, h, hd = qc.shape
    kvh = kc.shape[2]
    g = h // kvh
    q5 = qc.reshape(b, l, kvh, g, hd)
    sc = jnp.einsum('blkgd,bmkd->bkglm', q5, kc).astype(jnp.float32) * hd ** -0.5
    if sink is not None:
        sk = jnp.broadcast_to(sink.astype(jnp.float32).reshape(1, kvh, g, 1, 1), (b, kvh, g, l, 1))
        sc = jnp.concatenate([sc, sk], axis=-1)
    p = jax.nn.softmax(sc, axis=-1)[..., :l].astype(vc.dtype)
    return jnp.einsum('bkglm,bmkd->blkgd', p, vc).reshape(b, l, h * hd)


def fourier_mix(u):
    b, n, _ = u.shape
    u4 = u.astype(jnp.float32).reshape(b, n, FNET_GROUPS, FNET_GROUP_DIM)
    f = jnp.fft.fft2(u4, axes=(1, 3), norm='ortho').real
    return f.reshape(b, n, FNET_WIDTH).astype(u.dtype)


def project_groups(h, w_in):
    b, n, _ = h.shape
    aq, ak, av, bq, bk, bv, fu = jnp.split(h @ w_in, IN_SPLITS, axis=-1)
    heads = lambda t, nh: t.reshape(b, n, nh, HEAD_DIM)
    return (heads(aq, NA_HEADS), heads(ak, NA_HEADS), heads(av, NA_HEADS),
            heads(bq, SWA_HEADS), heads(bk, SWA_KV_HEADS), heads(bv, SWA_KV_HEADS), fu)


def mods_of(m, sub):
    return m[..., 3 * sub, :], m[..., 3 * sub + 1, :], m[..., 3 * sub + 2, :]


def ffn_sublayer(h, m, sub, g_pre, g_post, w1, w2):
    shift, scale, gate = mods_of(m, sub)
    y = swiglu(modulate(rms_norm(h, g_pre[sub]), shift, scale), w1, w2)
    return h + MACARON_WEIGHT * gate * rms_norm(y, g_post[sub])


def hybrid_layer(x, xc, mod, mod_c, g_pre, g_post, w_ffn_in, w_ffn_out, w_in, w_out, na_rpb, swa_sink, ctx_out):
    x = ffn_sublayer(x, mod, 0, g_pre, g_post, w_ffn_in[0], w_ffn_out[0])
    xc = ffn_sublayer(xc, mod_c, 0, g_pre, g_post, w_ffn_in[0], w_ffn_out[0])
    sh, sc, gt = mods_of(mod, 1)
    shc, scc, gtc = mods_of(mod_c, 1)
    h = modulate(rms_norm(x, g_pre[1]), sh, sc)
    hc = modulate(rms_norm(xc, g_pre[1]), shc, scc)
    aq, ak, av, bq, bk, bv, fu = project_groups(h, w_in)
    aqc, akc, avc, bqc, bkc, bvc, fuc = project_groups(hc, w_in)
    bq = axial_rope(bq)
    bk = axial_rope(bk)
    o_a = neighbourhood_attention(aq, ak, av, akc, avc, na_rpb)
    o_b = window_gqa_attention(bq, bk, bv, bkc, bvc, swa_sink)
    o_c = fourier_mix(fu)
    o = jnp.concatenate([o_a, o_b, o_c], axis=-1) @ w_out
    x = x + gt * rms_norm(o, g_post[1])
    x = ffn_sublayer(x, mod, 2, g_pre, g_post, w_ffn_in[1], w_ffn_out[1])
    if ctx_out:
        oc = jnp.concatenate([context_attention(aqc, akc, avc),
                              context_attention(bqc, bkc, bvc, swa_sink),
                              fourier_mix(fuc)], axis=-1) @ w_out
        xc = xc + gtc * rms_norm(oc, g_post[1])
        xc = ffn_sublayer(xc, mod_c, 2, g_pre, g_post, w_ffn_in[1], w_ffn_out[1])
    else:
        xc = None
    return x, xc


def setup_inputs(seed: int = 0) -> dict:
    key = jax.random.key(seed)
    ks = jax.random.split(key, 14)
    nrm = jax.random.normal
    f32 = jnp.float32
    return {
        'x': nrm(ks[0], (BATCH, SEQ, D_MODEL), f32),
        'c': nrm(ks[1], (BATCH, D_MODEL), f32),
        'ctx': nrm(ks[2], (BATCH, CTX_LEN, D_MODEL), f32),
        'c_ctx': nrm(ks[3], (D_MODEL,), f32),
        'w_mod': nrm(ks[4], (DEPTH, D_MODEL, N_MOD * D_MODEL), f32) * (0.5 * D_MODEL ** -0.5),
        'b_mod': nrm(ks[5], (DEPTH, N_MOD * D_MODEL), f32) * 0.01,
        'g_pre': 1.0 + 0.01 * nrm(ks[6], (DEPTH, N_SUB, D_MODEL), f32),
        'g_post': 1.0 + 0.01 * nrm(ks[7], (DEPTH, N_SUB, D_MODEL), f32),
        'w_ffn_in': nrm(ks[8], (DEPTH, 2, D_MODEL, 2 * D_FF), f32) * D_MODEL ** -0.5,
        'w_ffn_out': nrm(ks[9], (DEPTH, 2, D_FF, D_MODEL), f32) * D_FF ** -0.5,
        'w_in': nrm(ks[10], (DEPTH, D_MODEL, D_IN), f32) * D_MODEL ** -0.5,
        'w_out': nrm(ks[11], (DEPTH, D_MIX, D_MODEL), f32) * D_MIX ** -0.5,
        'na_rpb': nrm(ks[12], (DEPTH, NA_HEADS, 2 * NA_KR - 1, 2 * NA_KW - 1), f32) * 0.1,
        'swa_sink': nrm(ks[13], (DEPTH, SWA_HEADS), f32) * 0.5,
    }


def reference(x, c, ctx, c_ctx, w_mod, b_mod, g_pre, g_post, w_ffn_in, w_ffn_out, w_in, w_out, na_rpb, swa_sink):
    b = x.shape[0]
    xc = ctx
    c_act = jax.nn.silu(c)
    cc_act = jax.nn.silu(c_ctx)
    for layer in range(DEPTH):
        mod = (c_act @ w_mod[layer] + b_mod[layer]).reshape(b, 1, N_MOD, D_MODEL)
        mod_c = (cc_act @ w_mod[layer] + b_mod[layer]).reshape(N_MOD, D_MODEL)
        x, xc = hybrid_layer(x, xc, mod, mod_c, g_pre[layer], g_post[layer], w_ffn_in[layer], w_ffn_out[layer],
                             w_in[layer], w_out[layer], na_rpb[layer], swa_sink[layer],
                             ctx_out=(layer < DEPTH - 1))
    return x
```

```cpp
#include <hip/hip_runtime.h>
#include <hip/hip_cooperative_groups.h>
#include <cstdio>
namespace cg = cooperative_groups;

#ifndef PROBE_REP_PH
#define PROBE_REP_PH -1
#endif
#ifndef MK_MULTI
#define MK_MULTI 0
#endif

typedef unsigned short u16;
using bf16x8 = __attribute__((ext_vector_type(8))) short;
using bf16x4 = __attribute__((ext_vector_type(4))) short;
using f32x4  = __attribute__((ext_vector_type(4))) float;
#define DI __device__ __forceinline__

constexpr int D = 1024, NB = 8, SEQ = 4096, CTXL = 256, DFF = 2816, NMOD = 9;
constexpr int NLAT = NB * SEQ;
constexpr int NCTX = NB * CTXL;
constexpr int R = NLAT + NCTX;
constexpr int DIN = 2048, DINX = 2304;
constexpr int NTHREADS = 512;
constexpr float LOG2E = 1.4426950408889634f;
constexpr float QSCALE = 0.125f * LOG2E;

struct Params {
  const float *x, *c, *ctx, *c_ctx, *w_mod, *b_mod, *g_pre, *g_post, *w_ffn_in, *w_ffn_out, *w_in, *w_out, *na_rpb, *swa_sink;
  float *out, *xc, *mod;
  u16 *w1t, *w2t, *wint, *woutt, *dft, *dftc, *h, *hn, *y;
  u16 *aq, *ak, *avT, *avTc, *bq, *bk, *bvT, *bvTc, *pqT, *pqTc, *eo;
  unsigned *ctr, *bar;
};

typedef const __attribute__((address_space(4))) Params* PPtr;
DI int TID() { int t = threadIdx.x; asm volatile("" : "+v"(t)); return t; }
DI PPtr pp_fresh(PPtr p) { asm volatile("" : "+s"(p)); return p; }

typedef __bf16 bf16x2_t __attribute__((ext_vector_type(2)));
DI unsigned pack2(float a, float b) { bf16x2_t v = {(__bf16)a, (__bf16)b}; return __builtin_bit_cast(unsigned, v); }
DI u16 f2bf(float f) { return (u16)(pack2(f, 0.f) & 0xffffu); }
DI float bf2f(u16 h) { return __uint_as_float(((unsigned)h) << 16); }
DI uint2 pack4(f32x4 v) { uint2 w; w.x = pack2(v[0], v[1]); w.y = pack2(v[2], v[3]); return w; }

constexpr int BM = 256, BK = 64, HALF = 128, NXCD = 8, WGM = 8, HT = HALF * BK;
constexpr int GEMM_LDS = 8 * HT * 2;
constexpr int LDS_BYTES = 148480 + 64 + 2048 + 64;
constexpr int XB_ST_OFF = 148480 + 64 + 2048;
constexpr int F_AK = 384, F_BQ = 768, F_BK = 1152, F_AV = 1280, F_BV = 1664, F_P = 1792;

DI int lds_byte(int r, int c) {
  int st = (r >> 4) * 2 + (c >> 5), rr = r & 15, cc = c & 31, ob = rr * 64 + cc * 2;
  return st * 1024 + (ob ^ (((ob >> 9) & 1) << 5));
}
DI void stage_rc(int b, int& Rr, int& Cc) {
  int st = b / 1024, sb = b % 1024, swz = sb ^ (((sb >> 9) & 1) << 5);
  Rr = (st >> 1) * 16 + swz / 64; Cc = (st & 1) * 32 + (swz % 64) / 2;
}
DI void tile_coords(int w, int nM, int nN, int& pm, int& pn) {
  int nwg = nM * nN, q = nwg / NXCD, r = nwg % NXCD, xcd = w % NXCD, off = w / NXCD;
  int id = (xcd < r ? xcd * (q + 1) : r * (q + 1) + (xcd - r) * q) + off;
  int nig = WGM * nN, gid = id / nig, fm = gid * WGM, gsz = min(nM - fm, WGM);
  pm = fm + ((id % nig) % gsz); pn = (id % nig) / gsz;
}

struct Tile { const u16* A; const u16* Bt; u16* C; int K, brow, bcol, kind, ldc, dep  ; };
struct GemmDesc { const u16* A; const u16* Bt; u16* C; int M, N, K, kind, ldc, mode, ntiles; const u16* B2; unsigned* ctr; };

DI Tile tile_of(PPtr p, const GemmDesc& g, int w) {
  Tile t; t.A = g.A; t.Bt = g.Bt; t.C = g.C; t.K = g.K; t.kind = g.kind; t.ldc = g.ldc; t.dep = 0;
  if (g.mode == 1) {
    if (w < 128) { const int b = w >> 4, kb = (w & 15) >> 1, which = w & 1;
      t.A = p->dft + (size_t)which * 2048 * 4096; t.Bt = p->pqT + (size_t)which * (NB * 256 * SEQ) + (size_t)b * 256 * SEQ;
      t.brow = kb * 256; t.bcol = 0; t.C = p->eo + ((size_t)(which * NB + b) * 2048) * 256; t.ldc = 256; }
    else { int b = w - 128; t.A = p->dftc; t.Bt = p->pqTc + (size_t)b * 256 * 512; t.K = 512; t.brow = 0; t.bcol = 0; t.C = p->hn + (size_t)(NLAT + b * CTXL) * D + 768; }
  } else if (g.mode == 2) {
    int pm, pn;
    if (w < 136 * 5) { tile_coords(w, 136, 5, pm, pn); t.brow = pm * BM; t.bcol = pn * BM; t.kind = 2; }
    else { tile_coords(w - 136 * 5, 136, 4, pm, pn); t.A = g.Bt; t.Bt = g.A; t.brow = F_AV + pn * BM; t.bcol = pm * BM; t.kind = 3; }
  } else if (g.mode == 3) {
    const int nM = R / BM, nN = 2 * DFF / BM, nreg = nM * nN;
    if (w < nreg) { int pm, pn; tile_coords(w, nM, nN, pm, pn); pm = nM - 1 - pm; t.brow = pm * BM; t.bcol = pn * BM; t.dep = (pm >= NLAT / BM) ? 1 : 0; }
    else { const int j = w - nreg; t.A = p->h; t.Bt = g.B2; t.C = p->y; t.K = DFF; t.kind = 0; t.ldc = D; t.brow = NLAT + (j >> 2) * BM; t.bcol = (j & 3) * BM; t.dep = 2; }
  } else { int pm, pn; tile_coords(w, g.M / BM, g.N / BM, pm, pn); t.brow = pm * BM; t.bcol = pn * BM; }
  return t;
}

DI int stg_off(int rl, int bo) { return rl * 512 + ((((bo >> 4) ^ rl) & 31) << 4) + (bo & 15); }

DI void epi_staged(PPtr p, const Tile& T, const f32x4 (&acc)[2][2][4][2], char* stg, int tid) {
  const int wid = tid >> 6, lane = tid & 63, wr = wid >> 2, wc = wid & 3, fr = lane & 15, fq = lane >> 4;
  const int kind = T.kind;
  const bool lat2 = T.brow < NLAT;
  if (kind == 1) {
    _Pragma("unroll") for (int ai = 0; ai < 2; ++ai) _Pragma("unroll") for (int bj = 0; bj < 2; ++bj) _Pragma("unroll") for (int m = 0; m < 4; ++m) {
      const int rl = ai * HALF + wr * 64 + m * 16 + fr, bo = (bj * 64 + wc * 16 + fq * 4) * 2;
      const f32x4 v0 = acc[ai][bj][m][0], v1 = acc[ai][bj][m][1]; f32x4 h;
      _Pragma("unroll") for (int j = 0; j < 4; ++j) h[j] = v0[j] * __builtin_amdgcn_rcpf(1.f + __expf(-v0[j])) * v1[j];
      *(uint2*)(stg + rl * 256 + ((((bo >> 4) ^ rl) & 15) << 4) + (bo & 15)) = pack4(h);
    }
    asm volatile("s_waitcnt lgkmcnt(0)" ::: "memory"); __builtin_amdgcn_s_barrier();
    _Pragma("unroll") for (int i = 0; i < 8; ++i) {
      const int q = tid + i * NTHREADS, rl = q >> 4, cc = q & 15;
      const uint4 v = *(const uint4*)(stg + rl * 256 + (((cc ^ rl) & 15) << 4));
      u16* d = T.C + (size_t)(T.brow + rl) * DFF + (T.bcol >> 1) + cc * 8;
      if (T.dep == 1) {
        __hip_atomic_store((unsigned long long*)d, ((unsigned long long)v.y << 32) | v.x, __ATOMIC_RELAXED, __HIP_MEMORY_SCOPE_AGENT);
        __hip_atomic_store((unsigned long long*)d + 1, ((unsigned long long)v.w << 32) | v.z, __ATOMIC_RELAXED, __HIP_MEMORY_SCOPE_AGENT);
      }
      else *(uint4*)d = v;
    }
    asm volatile("s_waitcnt lgkmcnt(0)" ::: "memory"); __builtin_amdgcn_s_barrier();
    return;
  }
  _Pragma("unroll") for (int ai = 0; ai < 2; ++ai) {
    _Pragma("unroll") for (int bj = 0; bj < 2; ++bj) {
      const int gc = T.bcol + bj * HALF + wc * 32;
      float inv[4];
      const bool rope = (kind == 2) && (gc >= F_BQ) && lat2;
      if (rope) { _Pragma("unroll") for (int j = 0; j < 4; ++j) inv[j] = exp2f(-(float)(fq * 4 + j) * (13.287712379549449f / 16.f)); }
      _Pragma("unroll") for (int m = 0; m < 4; ++m) {
        const int rl = wr * 64 + m * 16 + fr;
        f32x4 v0 = acc[ai][bj][m][0], v1 = acc[ai][bj][m][1];
        if (kind == 1) {
          f32x4 h;
          _Pragma("unroll") for (int j = 0; j < 4; ++j) h[j] = v0[j] * __builtin_amdgcn_rcpf(1.f + __expf(-v0[j])) * v1[j];
          *(uint2*)(stg + stg_off(rl, (bj * 64 + wc * 16 + fq * 4) * 2)) = pack4(h);
        } else {
          if (rope) {
            const int s = (T.brow + ai * HALF + rl) & 4095; const float pos = (float)((gc & 32) ? (s & 63) : (s >> 6));
            _Pragma("unroll") for (int j = 0; j < 4; ++j) {
              const float ang = pos * inv[j], cs = __cosf(ang), sn = __sinf(ang), x1 = v0[j], x2 = v1[j];
              v0[j] = x1 * cs - x2 * sn; v1[j] = x1 * sn + x2 * cs;
            }
          }
          const int bo = (bj * HALF + wc * 32 + fq * 4) * 2;
          *(uint2*)(stg + stg_off(rl, bo)) = pack4(v0);
          *(uint2*)(stg + stg_off(rl, bo + 32)) = pack4(v1);
        }
      }
    }
    asm volatile("s_waitcnt lgkmcnt(0)" ::: "memory"); __builtin_amdgcn_s_barrier();
    if (kind == 1) {
      _Pragma("unroll") for (int i = 0; i < 4; ++i) {
        const int q = tid + i * NTHREADS, rl = q >> 4, cc = q & 15;
        const uint4 v = *(const uint4*)(stg + stg_off(rl, cc * 16));
        u16* d = T.C + (size_t)(T.brow + ai * HALF + rl) * DFF + (T.bcol >> 1) + cc * 8;
        if (T.dep == 1) {
          __hip_atomic_store((unsigned long long*)d, ((unsigned long long)v.y << 32) | v.x, __ATOMIC_RELAXED, __HIP_MEMORY_SCOPE_AGENT);
          __hip_atomic_store((unsigned long long*)d + 1, ((unsigned long long)v.w << 32) | v.z, __ATOMIC_RELAXED, __HIP_MEMORY_SCOPE_AGENT);
        }
        else *(uint4*)d = v;
      }
    } else {
      _Pragma("unroll") for (int i = 0; i < 8; ++i) {
        const int q = tid + i * NTHREADS, rl = q >> 5, cc = q & 31;
        const uint4 v = *(const uint4*)(stg + stg_off(rl, cc * 16));
        const int r = T.brow + ai * HALF + rl, c = T.bcol + cc * 8;
        u16* d;
        if (kind == 0) d = T.C + (size_t)r * T.ldc + c;
        else if (kind == 2) {
          d = (c < F_AK) ? p->aq + (size_t)r * 384 + c : (c < F_BQ) ? p->ak + (size_t)r * 384 + (c - F_AK)
            : (c < F_BK) ? p->bq + (size_t)r * 384 + (c - F_BQ) : p->bk + (size_t)r * 128 + (c - F_BK);
        } else {
          const bool lat = T.bcol < NLAT;
          const int b = lat ? (c >> 12) : ((c - NLAT) >> 8), s0 = lat ? (c & 4095) : ((c - NLAT) & 255);
          if (r < F_BV)     d = lat ? p->avT + ((size_t)b * 384 + (r - F_AV)) * SEQ + s0 : p->avTc + ((size_t)b * 384 + (r - F_AV)) * CTXL + s0;
          else if (r < F_P) d = lat ? p->bvT + ((size_t)b * 128 + (r - F_BV)) * SEQ + s0 : p->bvTc + ((size_t)b * 128 + (r - F_BV)) * CTXL + s0;
          else { const int ch = r - F_P, which = ch >> 8, cq = ch & 255;
                 d = lat ? p->pqT + (size_t)which * (NB * 256 * SEQ) + ((size_t)b * 256 + cq) * SEQ + s0 : p->pqTc + ((size_t)b * 256 + cq) * (2 * CTXL) + which * CTXL + s0; }
        }
        *(uint4*)d = v;
      }
    }
    asm volatile("s_waitcnt lgkmcnt(0)" ::: "memory"); __builtin_amdgcn_s_barrier();
  }
}

DI void gemm_run(u16* shm, PPtr p, const GemmDesc& g) {
#define SA(b, h) (shm + ((b) * 4 + (h)) * HT)
#define SB(b, h) (shm + ((b) * 4 + 2 + (h)) * HT)
#define STAGE(P, BASE, br, kt) do { unsigned long long _ga = (unsigned long long)((BASE) + (long)(br) * K + (long)(kt) * BK); \
    asm volatile("" : "+s"(_ga)); const char* _gb = (const char*)_ga; \
    __builtin_amdgcn_global_load_lds((const unsigned*)(_gb + voff0), (__attribute__((address_space(3))) unsigned*)((char*)(P) + tid * 16), 16, 0, 0); \
    __builtin_amdgcn_global_load_lds((const unsigned*)(_gb + voff1), (__attribute__((address_space(3))) unsigned*)((char*)(P) + tid * 16 + 8192), 16, 0, 0); } while (0)
#define LDA(dst, b, h) for (int m = 0; m < 4; ++m) for (int k = 0; k < 2; ++k) \
    dst[m][k] = *reinterpret_cast<const bf16x8*>((char*)SA(b, h) + lds_byte(wr * 64 + m * 16 + fr, k * 32 + fq * 8))
#define LDB(dst, b, h) for (int n = 0; n < 2; ++n) for (int k = 0; k < 2; ++k) \
    dst[n][k] = *reinterpret_cast<const bf16x8*>((char*)SB(b, h) + lds_byte(wc * 32 + n * 16 + fr, k * 32 + fq * 8))
#define MMA(ai, bj, At_, Bt_) do { __builtin_amdgcn_s_setprio(1); \
    for (int m = 0; m < 4; ++m) for (int n = 0; n < 2; ++n) for (int k = 0; k < 2; ++k) \
      acc[ai][bj][m][n] = __builtin_amdgcn_mfma_f32_16x16x32_bf16(Bt_[n][k], At_[m][k], acc[ai][bj][m][n], 0, 0, 0); \
    __builtin_amdgcn_s_setprio(0); } while (0)
#define WAIT_V(n) asm volatile("s_waitcnt vmcnt(" #n ")" ::: "memory")
#define WAIT_L(n) asm volatile("s_waitcnt lgkmcnt(" #n ")" ::: "memory")
#define BAR __builtin_amdgcn_s_barrier()
#define SCHED __builtin_amdgcn_sched_barrier(0)
#define SET_VOFF(KK) do { int _r, _c; stage_rc(tid * 16, _r, _c); voff0 = (unsigned)(_r * (KK) + _c) * 2u; \
    stage_rc(tid * 16 + 8192, _r, _c); voff1 = (unsigned)(_r * (KK) + _c) * 2u; } while (0)
#define ISSUE_FIRST() do { STAGE(SB(0, 0), Bt, bcol, 0); STAGE(SA(0, 0), A, brow, 0); STAGE(SB(0, 1), Bt, bcol + HALF, 0); STAGE(SA(0, 1), A, brow + HALF, 0); } while (0)
#define NEXT_W(it) ((g.mode != 3 || gridDim.x != 256) ? (((int)blockIdx.x + (it) * (int)gridDim.x < g.ntiles) ? (int)blockIdx.x + (it) * (int)gridDim.x : -1) \
    : ((int)blockIdx.x < 224 ? (((int)blockIdx.x + (it) * 224 < 2672) ? (int)blockIdx.x + (it) * 224 : -1) \
       : ((it) < 10 ? 2672 + ((int)blockIdx.x - 224) + (it) * 32 : ((it) == 10 ? 2992 + ((int)blockIdx.x - 224) : -1))))
  int it_ = 0;
  int w = NEXT_W(0);
  if (w < 0) return;
  const int tid = TID();
  const int wid = tid >> 6, lane = tid & 63, wr = wid >> 2, wc = wid & 3, fr = lane & 15, fq = lane >> 4;
#define DEP_WAIT() do { if (tid == 0) { while (__hip_atomic_load(g.ctr, __ATOMIC_RELAXED, __HIP_MEMORY_SCOPE_AGENT) < (unsigned)((NCTX / BM) * (2 * DFF / BM))) __builtin_amdgcn_s_sleep(16); } \
    __syncthreads(); __builtin_amdgcn_fence(__ATOMIC_ACQUIRE, "agent"); } while (0)
  Tile T = tile_of(p, g, w);
  const u16 *A = T.A, *Bt = T.Bt; int K = T.K, brow = T.brow, bcol = T.bcol;
  unsigned voff0, voff1;
  SET_VOFF(K);
  if (T.dep == 2) DEP_WAIT();
  ISSUE_FIRST();
#pragma unroll 1
  for (;;) {
    f32x4 acc[2][2][4][2] = {};
    bf16x8 At[4][2], B0[2][2], B1[2][2];
    const int nt = K / BK;
    if (wr == 1) BAR;
    WAIT_V(0); BAR;
    STAGE(SB(1, 0), Bt, bcol, 1); STAGE(SA(1, 0), A, brow, 1); STAGE(SB(1, 1), Bt, bcol + HALF, 1);
    WAIT_V(6); BAR;
    for (int t = 0; t < nt - 2; t += 2) {
      LDB(B0, 0, 0); SCHED; LDA(At, 0, 0); STAGE(SA(1, 1), A, brow + HALF, t + 1);
      WAIT_L(8); BAR; WAIT_L(0); MMA(0, 0, At, B0); BAR; SCHED;
      LDB(B1, 0, 1); STAGE(SB(0, 0), Bt, bcol, t + 2);
      BAR; WAIT_L(0); MMA(0, 1, At, B1); BAR;
      LDA(At, 0, 1); STAGE(SA(0, 0), A, brow, t + 2);
      BAR; WAIT_L(0); MMA(1, 0, At, B0); BAR; SCHED;
      STAGE(SB(0, 1), Bt, bcol + HALF, t + 2);
      WAIT_V(6); BAR; MMA(1, 1, At, B1); BAR;
      LDB(B0, 1, 0); SCHED; LDA(At, 1, 0); STAGE(SA(0, 1), A, brow + HALF, t + 2);
      WAIT_L(8); BAR; WAIT_L(0); MMA(0, 0, At, B0); BAR; SCHED;
      LDB(B1, 1, 1); STAGE(SB(1, 0), Bt, bcol, t + 3);
      BAR; WAIT_L(0); MMA(0, 1, At, B1); BAR;
      LDA(At, 1, 1); STAGE(SA(1, 0), A, brow, t + 3);
      BAR; WAIT_L(0); MMA(1, 0, At, B0); BAR; SCHED;
      STAGE(SB(1, 1), Bt, bcol + HALF, t + 3);
      WAIT_V(6); BAR; MMA(1, 1, At, B1); BAR;
    }
    { LDB(B0, 0, 0); LDA(At, 0, 0); STAGE(SA(1, 1), A, brow + HALF, nt - 1);
      BAR; WAIT_L(0); MMA(0, 0, At, B0); BAR;
      LDB(B1, 0, 1); BAR; WAIT_L(0); MMA(0, 1, At, B1); BAR;
      LDA(At, 0, 1); WAIT_V(4); BAR; WAIT_L(0); MMA(1, 0, At, B0); MMA(1, 1, At, B1); BAR; }
    { LDB(B0, 1, 0); LDA(At, 1, 0); WAIT_V(2); BAR; WAIT_L(0); MMA(0, 0, At, B0); BAR;
      LDB(B1, 1, 1); WAIT_V(0); BAR; WAIT_L(0); MMA(0, 1, At, B1); BAR;
      LDA(At, 1, 1); BAR; WAIT_L(0); MMA(1, 0, At, B0); MMA(1, 1, At, B1); BAR; }
    if (wr == 0) BAR;
    const Tile Tc = T;
    ++it_; w = NEXT_W(it_);
    const bool more = w >= 0;
    if (more) {
      T = tile_of(p, g, w); A = T.A; Bt = T.Bt; brow = T.brow; bcol = T.bcol;
      if (T.K != K) { K = T.K; SET_VOFF(K); }
      if (T.dep == 2) DEP_WAIT();
      ISSUE_FIRST();
    }
    epi_staged(pp_fresh(p), Tc, acc, (char*)shm + 65536, TID());
    if (Tc.dep == 1) {
      asm volatile("s_waitcnt vmcnt(0)" ::: "memory"); __syncthreads();
      if (tid == 0) __hip_atomic_fetch_add(g.ctr, 1u, __ATOMIC_RELAXED, __HIP_MEMORY_SCOPE_AGENT);
    }
    if (!more) break;
  }
#undef SA
#undef SB
#undef STAGE
#undef LDA
#undef LDB
#undef MMA
#undef SET_VOFF
#undef ISSUE_FIRST
#undef DEP_WAIT
#undef NEXT_W
}

DI int ffn_src_col(int n) { int blk = n >> 5, t = n & 31; return t < 16 ? blk * 16 + t : DFF + blk * 16 + (t - 16); }

DI void transpose_tile4(float* tl, const float* src, int ld_src, u16* dst, int Kd, int k0, int n0, int mode) {
  const int tid = TID();
  float v[4][8]; float sc[4];
  { const int nn = tid & 63, kb = tid >> 6;
    _Pragma("unroll") for (int sub = 0; sub < 4; ++sub) {
      const int n = n0 + sub * 64;
      int col; sc[sub] = 1.f;
      if (mode == 1) col = ffn_src_col(n + nn);
      else if (mode == 2) { const int coloff = (n < F_BQ) ? 0 : (n < F_AV) ? (1152 - F_BQ) : (n < F_BV) ? (768 - F_AV) : 0; col = n + nn + coloff;
                            sc[sub] = (n < F_AK || (n >= F_BQ && n < F_BK)) ? QSCALE : 1.f; }
      else col = n + nn;
      _Pragma("unroll") for (int i = 0; i < 8; ++i) v[sub][i] = src[(size_t)(k0 + kb + 8 * i) * ld_src + col];
    }
    _Pragma("unroll") for (int sub = 0; sub < 4; ++sub) _Pragma("unroll") for (int i = 0; i < 8; ++i) tl[sub * (64 * 65) + (kb + 8 * i) * 65 + nn] = v[sub][i] * sc[sub];
  }
  __syncthreads();
  { const int kk = (tid & 31) * 2, nb = tid >> 5;
    _Pragma("unroll") for (int sub = 0; sub < 4; ++sub) _Pragma("unroll") for (int i = 0; i < 4; ++i) { const int nn = nb + 16 * i;
      *(unsigned*)(dst + (size_t)(n0 + sub * 64 + nn) * Kd + k0 + kk) = pack2(tl[sub * (64 * 65) + kk * 65 + nn], tl[sub * (64 * 65) + (kk + 1) * 65 + nn]); } }
  __syncthreads();
}

DI void phase_prep(PPtr p, char* shmc) {
  float* tl = (float*)shmc;
  const int tid = TID();
  if (blockIdx.x == 0 && tid < 32) p->ctr[tid] = 0u;
  constexpr int N_W1 = 2 * 2 * 22 * 16, N_W2 = 2 * 2 * 4 * 44, N_WI = 2 * 7 * 16, N_WO = 2 * 4 * 16, N_FOLD = 2 * 4 * 16;
  constexpr int N_DFT = 4096, N_DFTC = 256, N_GEMV = 2 * 144;
  constexpr int O_W2 = N_W1, O_WI = O_W2 + N_W2, O_WO = O_WI + N_WI, O_FOLD = O_WO + N_WO, O_DFT = O_FOLD + N_FOLD, O_DFTC = O_DFT + N_DFT,
                O_GEMV = O_DFTC + N_DFTC, N_TOT = O_GEMV + N_GEMV;
#pragma unroll 1
  for (int it0 = blockIdx.x; it0 < N_TOT; it0 += gridDim.x) {
    int it = N_TOT - 1 - it0;
    if (it < O_W2) {
      int lf = it / (22 * 16), rem = it % (22 * 16), nt = rem / 16, kt = rem % 16;
      transpose_tile4(tl, p->w_ffn_in + (size_t)lf * D * 2 * DFF, 2 * DFF, p->w1t + (size_t)lf * 2 * DFF * D, D, kt * 64, nt * 256, 1);
    } else if (it < O_WI) {
      int i2 = it - O_W2; int lf = i2 / (4 * 44), rem = i2 % (4 * 44), nt = rem / 44, kt = rem % 44;
      transpose_tile4(tl, p->w_ffn_out + (size_t)lf * DFF * D, D, p->w2t + (size_t)lf * D * DFF, DFF, kt * 64, nt * 256, 0);
    } else if (it < O_WO) {
      int i2 = it - O_WI; int l = i2 / (7 * 16), rem = i2 % (7 * 16), nt = rem / 16, kt = rem % 16;
      transpose_tile4(tl, p->w_in + (size_t)l * D * DIN, DIN, p->wint + (size_t)l * DINX * D, D, kt * 64, nt * 256, 2);
    } else if (it < O_FOLD) {
      int i2 = it - O_WO; int l = i2 / 64, rem = i2 % 64, nt = rem / 16, kt = rem % 16;
      transpose_tile4(tl, p->w_out + (size_t)l * D * D, D, p->woutt + (size_t)l * D * D, D, kt * 64, nt * 256, 0);
    } else if (it < O_DFT) {
      int i2 = it - O_FOLD; int l = i2 / 64, g = (i2 % 64) / 16, kt = i2 % 16, k0 = kt * 64;
      float* twc = tl + 64 * 65; float* tws = twc + 64;
      { int nn = tid & 63, kb = tid >> 6;
        for (int i = 0; i < 8; ++i) { int kk = kb + 8 * i; tl[kk * 65 + nn] = p->w_in[(size_t)l * D * DIN + (size_t)(k0 + kk) * DIN + 1792 + g * 64 + nn]; } }
      if (tid < 64) { twc[tid] = cospif((float)tid / 32.f); tws[tid] = sinpif((float)tid / 32.f); }
      __syncthreads();
      { int kk = tid & 63, mg = tid >> 6;
#pragma unroll 1
        for (int i = 0; i < 16; ++i) {
          int mo = mg * 16 + i, which = mo >> 6, m = mo & 63;
          const float* tw = which ? tws : twc;
          float s = 0.f;
#pragma unroll 4
          for (int c = 0; c < 64; ++c) s += tl[kk * 65 + c] * tw[(m * c) & 63];
          p->wint[(size_t)l * DINX * D + (size_t)(1792 + which * 256 + g * 64 + m) * D + k0 + kk] = f2bf(s);
        } }
      __syncthreads();
    } else if (it < O_DFTC) {
      const int k = (it - O_DFT) & 2047, which = (it - O_DFT) >> 11;
      const int col0 = tid * 8; unsigned w[4];
      for (int e = 0; e < 4; ++e) {
        float v[2];
        for (int q = 0; q < 2; ++q) { const int n = col0 + e * 2 + q; const int j = (k * n) & 4095; const float a = (float)j / 2048.f;
          v[q] = (which ? sinpif(a) : cospif(a)) * (1.f / 512.f); }
        w[e] = pack2(v[0], v[1]);
      }
      uint4 o; o.x = w[0]; o.y = w[1]; o.z = w[2]; o.w = w[3];
      *(uint4*)(p->dft + ((size_t)which * 2048 + k) * 4096 + col0) = o;
    } else if (it < O_GEMV) {
      int k = it - O_DFTC; int col = tid; int n = col & 255; int j = (k * n) & 255; float a = (float)j / 128.f;
      float v = (col < 256) ? cospif(a) * (1.f / 128.f) : -sinpif(a) * (1.f / 128.f);
      p->dftc[k * 512 + col] = f2bf(v);
    } else {
      int i2 = it - O_GEMV; int l = i2 / 144, n0 = (i2 % 144) * 64;
      float* act = tl;
      float* red = tl + 1024 * 12;
      for (int e = tid; e < 9 * 1024; e += NTHREADS) {
        int bb = e >> 10, k = e & 1023; float v = (bb < 8) ? p->c[bb * D + k] : p->c_ctx[k];
        act[k * 12 + bb] = v / (1.f + __expf(-v));
      }
      __syncthreads();
      int col = tid & 63, kg = tid >> 6;
      float a[9]; for (int q = 0; q < 9; ++q) a[q] = 0.f;
      const float* wp = p->w_mod + (size_t)l * D * (NMOD * D) + n0 + col;
#pragma unroll 1
      for (int k0 = kg * 128; k0 < kg * 128 + 128; k0 += 16) {
        float wv[16];
        _Pragma("unroll") for (int j = 0; j < 16; ++j) wv[j] = wp[(size_t)(k0 + j) * (NMOD * D)];
        _Pragma("unroll") for (int j = 0; j < 16; ++j) {
          const int k = k0 + j; const float w = wv[j];
          f32x4 a0 = *(const f32x4*)(act + k * 12), a1 = *(const f32x4*)(act + k * 12 + 4); float a8 = act[k * 12 + 8];
          a[0] += a0[0] * w; a[1] += a0[1] * w; a[2] += a0[2] * w; a[3] += a0[3] * w;
          a[4] += a1[0] * w; a[5] += a1[1] * w; a[6] += a1[2] * w; a[7] += a1[3] * w; a[8] += a8 * w;
        }
      }
      for (int q = 0; q < 9; ++q) red[(kg * 9 + q) * 64 + col] = a[q];
      __syncthreads();
      for (int e = tid; e < 9 * 64; e += NTHREADS) {
        int q = e >> 6, cc = e & 63; float s = 0.f;
        for (int g = 0; g < 8; ++g) s += red[(g * 9 + q) * 64 + cc];
        p->mod[((size_t)l * 9 + q) * (NMOD * D) + n0 + cc] = s + p->b_mod[(size_t)l * (NMOD * D) + n0 + cc];
      }
      __syncthreads();
    }
  }
}

DI float wave_sum(float v) { for (int o = 32; o > 0; o >>= 1) v += __shfl_xor(v, o); return v; }

template <int RPW>
DI void norm_rows(PPtr p, int row0, int lane, int lp, int sp, int ln, int sn, bool first) {
  {
    const bool lat = row0 < NLAT; const int bidx = lat ? (row0 >> 12) : 8;
    const float* xin; float* xout;
    if (lat) { xout = p->out + (size_t)row0 * D; xin = first ? p->x + (size_t)row0 * D : xout; }
    else     { xout = p->xc + (size_t)(row0 - NLAT) * D; xin = first ? p->ctx + (size_t)(row0 - NLAT) * D : xout; }
    f32x4 xv[RPW][4]; uint2 yw[RPW][4];
    _Pragma("unroll") for (int r = 0; r < RPW; ++r) _Pragma("unroll") for (int i = 0; i < 4; ++i) xv[r][i] = *(const f32x4*)(xin + (size_t)r * D + i * 256 + lane * 4);
    if (sp >= 0) {
      _Pragma("unroll") for (int r = 0; r < RPW; ++r) _Pragma("unroll") for (int i = 0; i < 4; ++i) yw[r][i] = *(const uint2*)(p->y + (size_t)(row0 + r) * D + i * 256 + lane * 4);
      const float wgt = (sp == 1) ? 1.f : 0.5f;
      const float* gate = p->mod + ((size_t)lp * 9 + bidx) * (NMOD * D) + (3 * sp + 2) * D;
      const float* gp = p->g_post + ((size_t)lp * 3 + sp) * D;
      f32x4 gg[4];
      _Pragma("unroll") for (int i = 0; i < 4; ++i) { f32x4 g = *(const f32x4*)(gate + i * 256 + lane * 4), q = *(const f32x4*)(gp + i * 256 + lane * 4); gg[i] = g * q * wgt; }
      _Pragma("unroll") for (int r = 0; r < RPW; ++r) {
        f32x4 yv[4]; float ss = 0.f;
        _Pragma("unroll") for (int i = 0; i < 4; ++i) {
          yv[i][0] = __uint_as_float(yw[r][i].x << 16); yv[i][1] = __uint_as_float(yw[r][i].x & 0xffff0000u);
          yv[i][2] = __uint_as_float(yw[r][i].y << 16); yv[i][3] = __uint_as_float(yw[r][i].y & 0xffff0000u);
          _Pragma("unroll") for (int j = 0; j < 4; ++j) ss += yv[i][j] * yv[i][j];
        }
        ss = wave_sum(ss);
        const float rr = rsqrtf(ss * (1.f / D) + 1e-6f);
        _Pragma("unroll") for (int i = 0; i < 4; ++i) {
          _Pragma("unroll") for (int j = 0; j < 4; ++j) xv[r][i][j] += gg[i][j] * (yv[i][j] * rr);
          *(f32x4*)(xout + (size_t)r * D + i * 256 + lane * 4) = xv[r][i];
        }
      }
    }
    if (sn >= 0) {
      const float* sh = p->mod + ((size_t)ln * 9 + bidx) * (NMOD * D) + (3 * sn) * D;
      const float* sc = sh + D;
      const float* gq = p->g_pre + ((size_t)ln * 3 + sn) * D;
      f32x4 ma[4], mb[4];
      _Pragma("unroll") for (int i = 0; i < 4; ++i) {
        f32x4 a = *(const f32x4*)(sh + i * 256 + lane * 4), bb = *(const f32x4*)(sc + i * 256 + lane * 4), q = *(const f32x4*)(gq + i * 256 + lane * 4);
        ma[i] = q * (1.f + bb); mb[i] = a;
      }
      _Pragma("unroll") for (int r = 0; r < RPW; ++r) {
        float ss = 0.f;
        _Pragma("unroll") for (int i = 0; i < 4; ++i) _Pragma("unroll") for (int j = 0; j < 4; ++j) ss += xv[r][i][j] * xv[r][i][j];
        ss = wave_sum(ss);
        const float rr = rsqrtf(ss * (1.f / D) + 1e-6f);
        _Pragma("unroll") for (int i = 0; i < 4; ++i) {
          f32x4 ov = (xv[r][i] * rr) * ma[i] + mb[i];
          *(uint2*)(p->hn + (size_t)(row0 + r) * D + i * 256 + lane * 4) = pack4(ov);
        }
      }
    }
  }
}

DI void phase_norm(PPtr p, int M, int lp, int sp, int ln, int sn, bool first) {
  const int tid = TID(); const int lane = tid & 63;
  const int gw = blockIdx.x * (NTHREADS / 64) + (tid >> 6), nw = gridDim.x * (NTHREADS / 64);
  const int main_rows = (M / (nw * 4)) * (nw * 4);
#pragma unroll 1
  for (int row0 = gw * 4; row0 < main_rows; row0 += nw * 4) norm_rows<4>(p, row0, lane, lp, sp, ln, sn, first);
#pragma unroll 1
  for (int row0 = main_rows + gw; row0 < M; row0 += nw) norm_rows<1>(p, row0, lane, lp, sp, ln, sn, first);
}

struct AttnSt { f32x4 o[4]; float m, l; };
DI float ex2(float x) { return __builtin_amdgcn_exp2f(x); }
DI f32x4 mfma16(bf16x8 a, bf16x8 b, f32x4 c) { return __builtin_amdgcn_mfma_f32_16x16x32_bf16(a, b, c, 0, 0, 0); }
constexpr int ATT_K_BYTES = 576 * 128;
constexpr int ATT_V_BYTES = 64 * (576 * 2 + 16);
constexpr int ATT_LDS = ATT_K_BYTES + ATT_V_BYTES;

template <int NK>
DI void attn_fill(char* lds, const u16* kg, int ldk, const u16* vg, int ldv, int tid) {
  constexpr int PV = NK * 2 + 16, NCH = NK * 8 / NTHREADS;
  uint4 kr[NCH], vr[NCH];
  _Pragma("unroll") for (int i = 0; i < NCH; ++i) { const int id = tid + i * NTHREADS, key = id >> 3, c = id & 7;
    kr[i] = *(const uint4*)(kg + (size_t)key * ldk + c * 8); }
  _Pragma("unroll") for (int i = 0; i < NCH; ++i) { const int id = tid + i * NTHREADS, dim = id / (NK / 8), cc = id % (NK / 8);
    vr[i] = *(const uint4*)(vg + (size_t)dim * ldv + cc * 8); }
  _Pragma("unroll") for (int i = 0; i < NCH; ++i) { const int id = tid + i * NTHREADS, key = id >> 3, c = id & 7;
    *(uint4*)(lds + key * 128 + ((c ^ (key & 7)) << 4)) = kr[i]; }
  _Pragma("unroll") for (int i = 0; i < NCH; ++i) { const int id = tid + i * NTHREADS, dim = id / (NK / 8), cc = id % (NK / 8);
    *(uint4*)(lds + ATT_K_BYTES + dim * PV + cc * 16) = vr[i]; }
}

DI void lds_qk(const char* lds, int kk0, int kk1, int quad, bf16x8 q0, bf16x8 q1, f32x4& s0, f32x4& s1) {
  const char* r0 = lds + kk0 * 128; const char* r1 = lds + kk1 * 128;
  const bf16x8 k00 = *(const bf16x8*)(r0 + ((quad ^ (kk0 & 7)) << 4)), k01 = *(const bf16x8*)(r0 + (((4 + quad) ^ (kk0 & 7)) << 4));
  const bf16x8 k10 = *(const bf16x8*)(r1 + ((quad ^ (kk1 & 7)) << 4)), k11 = *(const bf16x8*)(r1 + (((4 + quad) ^ (kk1 & 7)) << 4));
  const f32x4 z = {0.f, 0.f, 0.f, 0.f};
  s0 = mfma16(k00, q0, z); s0 = mfma16(k01, q1, s0);
  s1 = mfma16(k10, q0, z); s1 = mfma16(k11, q1, s1);
}
DI void lds_pv(AttnSt& st, f32x4 s0, f32x4 s1, const char* lds, int pv, int fr, int kv0, int kv1) {
  float mx = fmaxf(fmaxf(fmaxf(s0[0], s0[1]), fmaxf(s0[2], s0[3])), fmaxf(fmaxf(s1[0], s1[1]), fmaxf(s1[2], s1[3])));
  mx = fmaxf(mx, __shfl_xor(mx, 16)); mx = fmaxf(mx, __shfl_xor(mx, 32));
  if (__builtin_amdgcn_ballot_w64(mx > st.m + 6.f)) {
    const float mn = fmaxf(st.m, mx), alpha = ex2(st.m - mn);
    st.m = mn; st.l *= alpha;
    _Pragma("unroll") for (int dt = 0; dt < 4; ++dt) st.o[dt] *= alpha;
  }
  const float mn = st.m;
  f32x4 p0, p1; float ls = 0.f;
  _Pragma("unroll") for (int j = 0; j < 4; ++j) { p0[j] = ex2(s0[j] - mn); p1[j] = ex2(s1[j] - mn); ls += p0[j] + p1[j]; }
  st.l += ls;
  union { bf16x8 v; uint2 h[2]; } pf; pf.h[0] = pack4(p0); pf.h[1] = pack4(p1);
  const char* vb = lds + ATT_K_BYTES + fr * pv;
  _Pragma("unroll") for (int dt = 0; dt < 4; ++dt) {
    union { bf16x8 v; uint2 h[2]; } vf;
    vf.h[0] = *(const uint2*)(vb + dt * 16 * pv + kv0 * 2); vf.h[1] = *(const uint2*)(vb + dt * 16 * pv + kv1 * 2);
    st.o[dt] = mfma16(vf.v, pf.v, st.o[dt]);
  }
}

DI void lds_qk2(const char* kA, const char* kB, int koff, bf16x8 q0, bf16x8 q1, f32x4& s0, f32x4& s1) {
  const bf16x8 k00 = *(const bf16x8*)(kA + koff), k01 = *(const bf16x8*)(kB + koff);
  const bf16x8 k10 = *(const bf16x8*)(kA + koff + 2048), k11 = *(const bf16x8*)(kB + koff + 2048);
  const f32x4 z = {0.f, 0.f, 0.f, 0.f};
  s0 = mfma16(k00, q0, z); s0 = mfma16(k01, q1, s0);
  s1 = mfma16(k10, q0, z); s1 = mfma16(k11, q1, s1);
}
template <int PV>
DI void lds_pv2(AttnSt& st, f32x4 s0, f32x4 s1, const char* vB, int voff) {
  float mx = fmaxf(fmaxf(fmaxf(s0[0], s0[1]), fmaxf(s0[2], s0[3])), fmaxf(fmaxf(s1[0], s1[1]), fmaxf(s1[2], s1[3])));
  mx = fmaxf(mx, __shfl_xor(mx, 16)); mx = fmaxf(mx, __shfl_xor(mx, 32));
  if (__builtin_amdgcn_ballot_w64(mx > st.m + 6.f)) {
    const float mn = fmaxf(st.m, mx), alpha = ex2(st.m - mn);
    st.m = mn; st.l *= alpha;
    _Pragma("unroll") for (int dt = 0; dt < 4; ++dt) st.o[dt] *= alpha;
  }
  const float mn = st.m;
  f32x4 p0, p1; float ls = 0.f;
  _Pragma("unroll") for (int j = 0; j < 4; ++j) { p0[j] = ex2(s0[j] - mn); p1[j] = ex2(s1[j] - mn); ls += p0[j] + p1[j]; }
  st.l += ls;
  union { bf16x8 v; uint2 h[2]; } pf; pf.h[0] = pack4(p0); pf.h[1] = pack4(p1);
  _Pragma("unroll") for (int dt = 0; dt < 4; ++dt) {
    union { bf16x8 v; uint2 h[2]; } vf;
    vf.h[0] = *(const uint2*)(vB + dt * 16 * PV + voff); vf.h[1] = *(const uint2*)(vB + dt * 16 * PV + voff + 32);
    st.o[dt] = mfma16(vf.v, pf.v, st.o[dt]);
  }
}

DI void attn_block(PPtr p, char* lds, int layer, int type, int b, int h, int idx, u16* o) {
  const int tid = TID(), wave = tid >> 6, lane = tid & 63, fr = lane & 15, quad = lane >> 4;
  const bool isA = (type == 0 || type == 2);
  const int kvh = h / 3, ldk = isA ? 384 : 128;
  const u16* Kall = isA ? p->ak + h * 64 : p->bk + kvh * 64;
  const u16* Kc = Kall + (size_t)(NLAT + b * CTXL) * ldk;
  const u16* Vc = isA ? p->avTc + (size_t)((b * 6 + h) * 64) * CTXL : p->bvTc + (size_t)((b * 2 + kvh) * 64) * CTXL;
  const u16* Vl = isA ? p->avT + (size_t)((b * 6 + h) * 64) * SEQ : p->bvT + (size_t)((b * 2 + kvh) * 64) * SEQ;
  int row;
  if (type == 0) row = b * SEQ + (idx * 2 + (wave >> 2)) * 64 + (wave & 3) * 16 + fr;
  else if (type == 1) row = b * SEQ + idx * 128 + wave * 16 + fr;
  else row = NLAT + b * CTXL + (idx * 8 + wave) * 16 + fr;
  const u16* qp = (isA ? p->aq : p->bq) + (size_t)row * 384 + h * 64 + quad * 8;
  const bf16x8 q0 = *(const bf16x8*)qp, q1 = *(const bf16x8*)(qp + 32);
  AttnSt st; for (int d = 0; d < 4; ++d) st.o[d] = f32x4{0.f, 0.f, 0.f, 0.f}; st.m = -1e30f; st.l = 0.f;
  __syncthreads();
  if (type == 0) {
    const int r0 = idx * 2, r = r0 + (wave >> 2), jb = wave & 3;
    const int kb = min(min(max(r0 - 4, 0), 56), 55);
    attn_fill<576>(lds, Kall + (size_t)(b * SEQ + kb * 64) * ldk, ldk, Vl + kb * 64, SEQ, tid);
    float* rpb = (float*)(lds + ATT_LDS + 64);
    if (tid < 15 * 31) rpb[tid] = p->na_rpb[((size_t)layer * 6 + h) * (15 * 31) + tid] * LOG2E;
    __syncthreads();
    const int rs = min(max(r - 4, 0), 56), kst = min(max(jb * 16 - 8, 0), 32), qc = jb * 16 + fr, ws = min(max(qc - 8, 0), 48);
    const int kbase0 = (rs - kb) * 64 + kst;
    const char* kA = lds + (kbase0 + fr) * 128 + ((quad ^ (fr & 7)) << 4);
    const char* kB = lds + (kbase0 + fr) * 128 + (((4 + quad) ^ (fr & 7)) << 4);
    const char* vB = lds + ATT_K_BYTES + fr * (576 * 2 + 16) + quad * 8 + kbase0 * 2;
    const float* rb0 = rpb + (rs - r + 7) * 31;
    bool va[4], vb[4]; const float* ba[4]; const float* bb[4];
    _Pragma("unroll") for (int j = 0; j < 4; ++j) {
      const int kc0 = kst + quad * 4 + j, kc1 = kc0 + 16;
      va[j] = (kc0 >= ws) && (kc0 < ws + 16); vb[j] = (kc1 >= ws) && (kc1 < ws + 16);
      ba[j] = rb0 + min(max(kc0 - qc + 15, 0), 30); bb[j] = rb0 + min(max(kc1 - qc + 15, 0), 30);
    }
    _Pragma("unroll") for (int i = 0; i < 8; ++i) {
      f32x4 s0, s1;
      lds_qk2(kA, kB, i * 8192, q0, q1, s0, s1);
      _Pragma("unroll") for (int j = 0; j < 4; ++j) {
        s0[j] = va[j] ? s0[j] + ba[j][i * 31] : -1e30f;
        s1[j] = vb[j] ? s1[j] + bb[j][i * 31] : -1e30f;
      }
      lds_pv2<576 * 2 + 16>(st, s0, s1, vB, i * 128);
    }
    __syncthreads();
  } else if (type == 1) {
    const int p0 = idx * 128, kb = min(max(p0 - 128, 0), SEQ - 384);
    attn_fill<384>(lds, Kall + (size_t)(b * SEQ + kb) * ldk, ldk, Vl + kb, SEQ, tid);
    __syncthreads();
    const int q0pos = p0 + wave * 16, qpos = q0pos + fr;
#pragma unroll 1
    for (int i = 0; i < 9; ++i) {
      const int ks = q0pos - 128 + i * 32;
      if (ks + 32 <= 0 || ks >= SEQ) continue;
      const int kl = ks - kb;
      f32x4 s0, s1;
      lds_qk(lds, min(max(kl + fr, 0), 383), min(max(kl + 16 + fr, 0), 383), quad, q0, q1, s0, s1);
      _Pragma("unroll") for (int j = 0; j < 4; ++j) {
        const int k0 = ks + quad * 4 + j, k1 = k0 + 16, d0 = k0 - qpos, d1 = k1 - qpos;
        s0[j] = ((d0 >= -128) && (d0 <= 128) && (k0 >= 0) && (k0 < SEQ)) ? s0[j] : -1e30f;
        s1[j] = ((d1 >= -128) && (d1 <= 128) && (k1 >= 0) && (k1 < SEQ)) ? s1[j] : -1e30f;
      }
      lds_pv(st, s0, s1, lds, 384 * 2 + 16, fr, min(max(kl + quad * 4, 0), 380), min(max(kl + 16 + quad * 4, 0), 380));
    }
    __syncthreads();
  }
  attn_fill<256>(lds, Kc, ldk, Vc, CTXL, tid);
  __syncthreads();
  { const char* kA = lds + fr * 128 + ((quad ^ (fr & 7)) << 4);
    const char* kB = lds + fr * 128 + (((4 + quad) ^ (fr & 7)) << 4);
    const char* vB = lds + ATT_K_BYTES + fr * (256 * 2 + 16) + quad * 8;
    _Pragma("unroll") for (int i = 0; i < 8; ++i) {
      f32x4 s0, s1;
      lds_qk2(kA, kB, i * 4096, q0, q1, s0, s1);
      lds_pv2<256 * 2 + 16>(st, s0, s1, vB, i * 64);
    } }
  float l = st.l; l += __shfl_xor(l, 16); l += __shfl_xor(l, 32);
  if (!isA) l += ex2(p->swa_sink[layer * 6 + h] * LOG2E - st.m);
  const float inv = 1.f / l;
  u16* orow = o + (size_t)row * D + (isA ? 0 : 384) + h * 64;
  _Pragma("unroll") for (int dt = 0; dt < 4; ++dt) *(uint2*)(orow + dt * 16 + quad * 4) = pack4(st.o[dt] * inv);
}

struct LFr { bf16x8 k00, k01, k10, k11; uint2 v[8]; };
DI void lds_load(LFr& f, const char* lds, int pv, int fr, int quad, int kk0, int kk1, int kv0, int kv1) {
  const char* r0 = lds + kk0 * 128; const char* r1 = lds + kk1 * 128;
  f.k00 = *(const bf16x8*)(r0 + ((quad ^ (kk0 & 7)) << 4)); f.k01 = *(const bf16x8*)(r0 + (((4 + quad) ^ (kk0 & 7)) << 4));
  f.k10 = *(const bf16x8*)(r1 + ((quad ^ (kk1 & 7)) << 4)); f.k11 = *(const bf16x8*)(r1 + (((4 + quad) ^ (kk1 & 7)) << 4));
  const char* vb = lds + ATT_K_BYTES + fr * pv;
  _Pragma("unroll") for (int dt = 0; dt < 4; ++dt) { f.v[dt * 2] = *(const uint2*)(vb + dt * 16 * pv + kv0 * 2); f.v[dt * 2 + 1] = *(const uint2*)(vb + dt * 16 * pv + kv1 * 2); }
}
DI void frag_qk(const LFr& f, bf16x8 q0, bf16x8 q1, f32x4& s0, f32x4& s1) {
  const f32x4 z = {0.f, 0.f, 0.f, 0.f};
  s0 = mfma16(f.k00, q0, z); s0 = mfma16(f.k01, q1, s0);
  s1 = mfma16(f.k10, q0, z); s1 = mfma16(f.k11, q1, s1);
}
DI void frag_pv(AttnSt& st, f32x4 s0, f32x4 s1, const LFr& f) {
  float mx = fmaxf(fmaxf(fmaxf(s0[0], s0[1]), fmaxf(s0[2], s0[3])), fmaxf(fmaxf(s1[0], s1[1]), fmaxf(s1[2], s1[3])));
  mx = fmaxf(mx, __shfl_xor(mx, 16)); mx = fmaxf(mx, __shfl_xor(mx, 32));
  if (__builtin_amdgcn_ballot_w64(mx > st.m + 6.f)) {
    const float mn = fmaxf(st.m, mx), alpha = ex2(st.m - mn);
    st.m = mn; st.l *= alpha;
    _Pragma("unroll") for (int dt = 0; dt < 4; ++dt) st.o[dt] *= alpha;
  }
  const float mn = st.m;
  f32x4 p0, p1; float ls = 0.f;
  _Pragma("unroll") for (int j = 0; j < 4; ++j) { p0[j] = ex2(s0[j] - mn); p1[j] = ex2(s1[j] - mn); ls += p0[j] + p1[j]; }
  st.l += ls;
  union { bf16x8 v; uint2 h[2]; } pf; pf.h[0] = pack4(p0); pf.h[1] = pack4(p1);
  _Pragma("unroll") for (int dt = 0; dt < 4; ++dt) {
    union { bf16x8 v; uint2 h[2]; } vf; vf.h[0] = f.v[dt * 2]; vf.h[1] = f.v[dt * 2 + 1];
    st.o[dt] = mfma16(vf.v, pf.v, st.o[dt]);
  }
}

DI void attn_block_swa3(PPtr p, char* lds, int layer, int b, int kvh, int idx, u16* o) {
  const int tid = TID(), wave = tid >> 6, lane = tid & 63, fr = lane & 15, quad = lane >> 4;
  const int ldk = 128;
  const u16* Kall = p->bk + kvh * 64;
  const u16* Kc = Kall + (size_t)(NLAT + b * CTXL) * ldk;
  const u16* Vc = p->bvTc + (size_t)((b * 2 + kvh) * 64) * CTXL;
  const u16* Vl = p->bvT + (size_t)((b * 2 + kvh) * 64) * SEQ;
  const int p0 = idx * 128, q0pos = p0 + wave * 16, qpos = q0pos + fr, row = b * SEQ + qpos;
  bf16x8 q0[3], q1[3]; AttnSt st[3];
  _Pragma("unroll") for (int hh = 0; hh < 3; ++hh) {
    const u16* qp = p->bq + (size_t)row * 384 + (kvh * 3 + hh) * 64 + quad * 8;
    q0[hh] = *(const bf16x8*)qp; q1[hh] = *(const bf16x8*)(qp + 32);
    for (int d = 0; d < 4; ++d) st[hh].o[d] = f32x4{0.f, 0.f, 0.f, 0.f}; st[hh].m = -1e30f; st[hh].l = 0.f;
  }
  __syncthreads();
  const int kb = min(max(p0 - 128, 0), SEQ - 384);
  attn_fill<384>(lds, Kall + (size_t)(b * SEQ + kb) * ldk, ldk, Vl + kb, SEQ, tid);
  __syncthreads();
#pragma unroll 1
  for (int i = 0; i < 9; ++i) {
    const int ks = q0pos - 128 + i * 32;
    if (ks + 32 <= 0 || ks >= SEQ) continue;
    const int kl = ks - kb;
    LFr f;
    lds_load(f, lds, 384 * 2 + 16, fr, quad, min(max(kl + fr, 0), 383), min(max(kl + 16 + fr, 0), 383),
             min(max(kl + quad * 4, 0), 380), min(max(kl + 16 + quad * 4, 0), 380));
    bool v0[4], v1[4];
    _Pragma("unroll") for (int j = 0; j < 4; ++j) {
      const int k0 = ks + quad * 4 + j, k1 = k0 + 16, d0 = k0 - qpos, d1 = k1 - qpos;
      v0[j] = (d0 >= -128) && (d0 <= 128) && (k0 >= 0) && (k0 < SEQ); v1[j] = (d1 >= -128) && (d1 <= 128) && (k1 >= 0) && (k1 < SEQ);
    }
    _Pragma("unroll") for (int hh = 0; hh < 3; ++hh) {
      f32x4 s0, s1;
      frag_qk(f, q0[hh], q1[hh], s0, s1);
      _Pragma("unroll") for (int j = 0; j < 4; ++j) { s0[j] = v0[j] ? s0[j] : -1e30f; s1[j] = v1[j] ? s1[j] : -1e30f; }
      frag_pv(st[hh], s0, s1, f);
    }
  }
  __syncthreads();
  attn_fill<256>(lds, Kc, ldk, Vc, CTXL, tid);
  __syncthreads();
#pragma unroll 1
  for (int i = 0; i < 8; ++i) {
    LFr f;
    lds_load(f, lds, 256 * 2 + 16, fr, quad, i * 32 + fr, i * 32 + 16 + fr, i * 32 + quad * 4, i * 32 + 16 + quad * 4);
    _Pragma("unroll") for (int hh = 0; hh < 3; ++hh) { f32x4 s0, s1; frag_qk(f, q0[hh], q1[hh], s0, s1); frag_pv(st[hh], s0, s1, f); }
  }
  _Pragma("unroll") for (int hh = 0; hh < 3; ++hh) {
    const int hq = kvh * 3 + hh;
    float l = st[hh].l; l += __shfl_xor(l, 16); l += __shfl_xor(l, 32);
    l += ex2(p->swa_sink[layer * 6 + hq] * LOG2E - st[hh].m);
    const float inv = 1.f / l;
    u16* orow = o + (size_t)row * D + 384 + hq * 64;
    _Pragma("unroll") for (int dt = 0; dt < 4; ++dt) *(uint2*)(orow + dt * 16 + quad * 4) = pack4(st[hh].o[dt] * inv);
  }
}

DI void phase_mixer(PPtr p, char* shmc, int layer, int rep) {
  volatile int* s_item = (volatile int*)(shmc + ATT_LDS);
  u16* o = p->hn;
  const bool ctx_out = (layer == 0);
  const int nNA = 1536, nSWA = 512, nC = ctx_out ? 192 : 0;
  const int total = nNA + nSWA + nC;
  const int tid = TID();
  for (;;) {
    __syncthreads();
    if (tid == 0) *s_item = (int)atomicAdd(p->ctr + layer + 2 * rep, 1u);
    __syncthreads();
    const int it = __builtin_amdgcn_readfirstlane(*s_item);
    if (it >= total) break;
    int type, b, h, idx;
    if (it < nNA) { type = 0; int bh = it >> 5; idx = it & 31; b = bh / 6; h = bh % 6; }
    else if (it < nNA + nSWA) { type = 1; int id = it - nNA; int bkv = id >> 5; idx = id & 31; b = bkv >> 1; h = bkv & 1; }
    else { int id = it - nNA - nSWA; type = 2 + id / 96; int r2 = id % 96; int bh = r2 >> 1; idx = r2 & 1; b = bh / 6; h = bh % 6; }
    if (type == 1) attn_block_swa3(p, shmc, layer, b, h, idx, o); else attn_block(p, shmc, layer, type, b, h, idx, o);
  }
}

DI void phase_fnet_combine(PPtr p) {
  const int tid = TID(); const int gt = blockIdx.x * NTHREADS + tid, nthr = gridDim.x * NTHREADS;
  u16* o = p->hn;
#pragma unroll 1
  for (int id = gt; id < NB * 2048 * 32; id += nthr) {
    const int c8 = (id & 31) * 8, k = (id >> 5) & 2047, b = id >> 16;
    const uint4 e = *(const uint4*)(p->eo + ((size_t)b * 2048 + k) * 256 + c8);
    const uint4 q = *(const uint4*)(p->eo + ((size_t)(NB + b) * 2048 + k) * 256 + c8);
    const unsigned ew[4] = {e.x, e.y, e.z, e.w}, qw[4] = {q.x, q.y, q.z, q.w}; unsigned f1[4], f2[4];
    _Pragma("unroll") for (int i = 0; i < 4; ++i) {
      const float el = __uint_as_float(ew[i] << 16), eh = __uint_as_float(ew[i] & 0xffff0000u), ql = __uint_as_float(qw[i] << 16), qh = __uint_as_float(qw[i] & 0xffff0000u);
      f1[i] = pack2(el - ql, eh - qh); f2[i] = pack2(el + ql, eh + qh);
    }
    uint4 v1; v1.x = f1[0]; v1.y = f1[1]; v1.z = f1[2]; v1.w = f1[3];
    *(uint4*)(o + ((size_t)b * SEQ + k) * D + 768 + c8) = v1;
    if (k > 0) { uint4 v2; v2.x = f2[0]; v2.y = f2[1]; v2.z = f2[2]; v2.w = f2[3]; *(uint4*)(o + ((size_t)b * SEQ + (SEQ - k)) * D + 768 + c8) = v2; }
  }
  const int gw = gt >> 6, lane = tid & 63;
#pragma unroll 1
  for (int id = gw; id < NB * 256; id += (nthr >> 6)) {
    const int b = id >> 8, ch = id & 255;
    const u16* pr = p->pqT + ((size_t)b * 256 + ch) * SEQ;
    float sacc = 0.f;
    _Pragma("unroll") for (int i = 0; i < 8; ++i) {
      const uint4 v = *(const uint4*)(pr + (i * 64 + lane) * 8);
      const unsigned vw[4] = {v.x, v.y, v.z, v.w};
      _Pragma("unroll") for (int j = 0; j < 4; ++j) sacc += __uint_as_float(vw[j] << 16) - __uint_as_float(vw[j] & 0xffff0000u);
    }
    sacc = wave_sum(sacc);
    if (lane == 0) o[((size_t)b * SEQ + 2048) * D + 768 + ch] = f2bf(sacc * (1.f / 512.f));
  }
}

#define XB_TMO      128
#define XB_XCNT(j)  (256  + 64 * (j))
#define XB_XSUB(j)  (1280 + 64 * (j))
#define XB_XGEN(j)  (2304 + 64 * (j))
#define XB_TOP      3328
#define XB_TOPGEN   3392
#define XCD_BAR_WORDS 3456
#define XB_SPIN_CAP (1u << 18)
#define LAS __attribute__((address_space(3)))
DI unsigned xb_ld(unsigned* p)              { return __hip_atomic_load(p, __ATOMIC_RELAXED, __HIP_MEMORY_SCOPE_AGENT); }
DI unsigned xb_add(unsigned* p, unsigned v) { return __hip_atomic_fetch_add(p, v, __ATOMIC_RELAXED, __HIP_MEMORY_SCOPE_AGENT); }
DI unsigned xb_xcc_id() { return (unsigned)__builtin_amdgcn_s_getreg((3 << 11) | 20) & 0xFu; }
#define XB_SPIN(cond, bar) do { unsigned _sp = 0; while (cond) { __builtin_amdgcn_s_sleep(1); \
    if ((++_sp & 255u) == 0u) { if (xb_ld(&(bar)[XB_TMO])) break; if (_sp > XB_SPIN_CAP) { atomicAdd(&(bar)[XB_TMO], 1u); break; } } } } while (0)
struct XcdBarrier { unsigned* bar; unsigned x; volatile LAS unsigned* st; };
DI XcdBarrier xcd_barrier_post(unsigned* bar, volatile LAS unsigned* st) {
    XcdBarrier b; b.bar = bar; b.x = xb_xcc_id(); b.st = st;
    if (threadIdx.x == 0) (void)xb_add(&bar[XB_XCNT(b.x)], 1u);
    return b;
}
DI void xcd_barrier_complete(unsigned* bar, unsigned x, unsigned& nloc, unsigned& nx) {
    const unsigned G = gridDim.x * gridDim.y * gridDim.z;
    unsigned sum, cnt, mine, sp = 0u;
    for (;;) {
        sum = 0u; cnt = 0u; mine = 0u;
#pragma unroll
        for (unsigned j = 0; j < 16; ++j) { const unsigned c = xb_ld(&bar[XB_XCNT(j)]); sum += c; cnt += (c > 0u) ? 1u : 0u; mine = (j == x) ? c : mine; }
        if (sum == G) break;
        __builtin_amdgcn_s_sleep(1);
        if ((++sp & 255u) == 0u) { if (xb_ld(&bar[XB_TMO])) break; if (sp > XB_SPIN_CAP) { atomicAdd(&bar[XB_TMO], 1u); break; } }
    }
    nloc = mine > 0u ? mine : 1u; nx = cnt > 0u ? cnt : 1u;
}
DI void xcd_barrier(const XcdBarrier& b) {
    asm volatile("s_waitcnt vmcnt(0)" ::: "memory");
    __syncthreads();
    if (threadIdx.x == 0) {
        unsigned* bar = b.bar;
        __builtin_amdgcn_s_waitcnt(0);
        unsigned nloc = b.st[0], nx = b.st[1];
        if (nloc == 0u) { xcd_barrier_complete(bar, b.x, nloc, nx); b.st[0] = nloc; b.st[1] = nx; }
        const unsigned old = xb_add(&bar[XB_XSUB(b.x)], 1u);
        const unsigned gen = old / nloc;
        if (old + 1u == (gen + 1u) * nloc) {
            __builtin_amdgcn_fence(__ATOMIC_RELEASE, "agent");
            asm volatile("s_waitcnt vmcnt(0)" ::: "memory");
            const unsigned og = xb_add(&bar[XB_TOP], 1u);
            const unsigned tg = og / nx;
            if (og + 1u == (tg + 1u) * nx) xb_add(&bar[XB_TOPGEN], 1u);
            else XB_SPIN(xb_ld(&bar[XB_TOPGEN]) == tg, bar);
            __builtin_amdgcn_fence(__ATOMIC_ACQUIRE, "agent");
            xb_add(&bar[XB_XGEN(b.x)], 1u);
            asm volatile("s_waitcnt vmcnt(0)" ::: "memory");
        } else {
            XB_SPIN(xb_ld(&bar[XB_XGEN(b.x)]) == gen, bar);
            __builtin_amdgcn_fence(__ATOMIC_ACQUIRE, "agent");
            asm volatile("s_waitcnt vmcnt(0)" ::: "memory");
        }
    }
    __syncthreads();
}

constexpr int N_PHASES = 2 + 2 * 10;

__global__ void __launch_bounds__(NTHREADS) mega_kernel(Params p_arg, int ph_lo, int ph_hi) {
  extern __shared__ __attribute__((aligned(16))) char shmc[];
  u16* shm = (u16*)shmc;
  PPtr p = (PPtr)__builtin_amdgcn_kernarg_segment_ptr();
  volatile LAS unsigned* xst = (volatile LAS unsigned*)(shmc + XB_ST_OFF);
  if (threadIdx.x == 0) { xst[0] = 0u; xst[1] = 0u; }
  __syncthreads();
  const XcdBarrier xb = xcd_barrier_post(p->bar, xst);
#pragma unroll 1
  for (int ph = ph_lo; ph < ph_hi; ++ph) {
    p = pp_fresh(p);
    const int l = (ph >= 2) ? (ph - 2) / 10 : 0, s = (ph >= 2) ? (ph - 2) % 10 : -1;
    const int Mfull = R, Mlate = (l == 0) ? R : NLAT;
#pragma unroll 1
    for (int rep = 0; rep < ((ph == PROBE_REP_PH) ? 2 : 1); ++rep) {
    GemmDesc g{}; g.ntiles = 0;
    if (s == 0)      g = GemmDesc{p->hn, p->w1t + (size_t)(l * 2 + 0) * 2 * DFF * D, p->h,  Mfull, 2 * DFF, D,    1, 0, 3, 0, p->w2t + (size_t)(l * 2 + 0) * D * DFF, p->ctr + 8 + l * 2};
    else if (s == 1) g = GemmDesc{p->h,  p->w2t + (size_t)(l * 2 + 0) * D * DFF,     p->y,  NLAT,  D,       DFF,  0, D, 0, 0};
    else if (s == 3) g = GemmDesc{p->hn, p->wint + (size_t)l * DINX * D,             nullptr, Mfull, DINX,  D,    2, 0, 2, 0};
    else if (s == 4) g = GemmDesc{p->dft, p->pqT,                                    p->hn, 0,     0,       4096, 0, D, 1, 0};
    else if (s == 5) g = GemmDesc{p->hn, p->woutt + (size_t)l * D * D,               p->y,  Mlate, D,       D,    0, D, 0, 0};
    else if (s == 7) g = GemmDesc{p->hn, p->w1t + (size_t)(l * 2 + 1) * 2 * DFF * D, p->h,  Mlate, 2 * DFF, D,    1, 0, (l == 0) ? 3 : 0, 0, p->w2t + (size_t)(l * 2 + 1) * D * DFF, p->ctr + 8 + l * 2 + 1};
    else if (s == 8) g = GemmDesc{p->h,  p->w2t + (size_t)(l * 2 + 1) * D * DFF,     p->y,  NLAT,  D,       DFF,  0, D, 0, 0};
    if (s == 5) { phase_fnet_combine(p); xcd_barrier(xb); }
    g.ntiles = (g.mode == 1) ? (128 + (l == 0 ? 8 : 0)) : (g.mode == 3) ? (R / BM) * (2 * DFF / BM) + (NCTX / BM) * (D / BM) : (g.M / BM) * (g.N / BM);
    if (g.ntiles > 0) gemm_run(shm, p, g);
    if (ph == 0) phase_prep(p, shmc);
    else if (ph == 1 || s == 2 || s == 6 || s == 9) {
      int M = Mlate, lp = l, sp = -1, ln = l, sn = -1; bool first = false;
      if (ph == 1) { M = R; sn = 0; first = true; }
      else if (s == 2) { M = Mfull; sp = 0; sn = 1; first = (l == 0); }
      else if (s == 6) { sp = 1; sn = 2; }
      else { sp = 2; ln = l + 1; sn = (l == 0) ? 0 : -1; }
      phase_norm(p, M, lp, sp, ln, sn, first);
    } else if (s == 4) phase_mixer(p, shmc, l, rep);
    }
    if (ph + 1 < ph_hi) {
      if (ph_hi > 1000) cg::this_grid().sync();
      xcd_barrier(xb);
    }
  }
}

extern "C" void kernel_launch(void* const* d_in, const int* in_sizes, int n_in, void* d_out, int out_size, void* d_ws, size_t ws_size,
                              hipStream_t stream) {
  Params p{};
  p.x = (const float*)d_in[0]; p.c = (const float*)d_in[1]; p.ctx = (const float*)d_in[2]; p.c_ctx = (const float*)d_in[3];
  p.w_mod = (const float*)d_in[4]; p.b_mod = (const float*)d_in[5]; p.g_pre = (const float*)d_in[6]; p.g_post = (const float*)d_in[7];
  p.w_ffn_in = (const float*)d_in[8]; p.w_ffn_out = (const float*)d_in[9]; p.w_in = (const float*)d_in[10]; p.w_out = (const float*)d_in[11];
  p.na_rpb = (const float*)d_in[12]; p.swa_sink = (const float*)d_in[13];
  p.out = (float*)d_out;
  char* w = (char*)d_ws; size_t off = 0;
  auto take = [&](size_t bytes) { char* r = w + off; off += (bytes + 255) & ~(size_t)255; return r; };
  p.ctr = (unsigned*)take(256);
  p.bar = (unsigned*)take(XCD_BAR_WORDS * 4);
  p.mod = (float*)take((size_t)2 * 9 * NMOD * D * 4);
  p.xc = (float*)take((size_t)NCTX * D * 4);
  p.w1t = (u16*)take((size_t)4 * 2 * DFF * D * 2);
  p.w2t = (u16*)take((size_t)4 * D * DFF * 2);
  p.wint = (u16*)take((size_t)2 * DINX * D * 2);
  p.woutt = (u16*)take((size_t)2 * D * D * 2);
  p.dft = (u16*)take((size_t)2 * 2048 * 4096 * 2);
  p.eo = (u16*)take((size_t)2 * NB * 2048 * 256 * 2);
  p.dftc = (u16*)take((size_t)256 * 512 * 2);
  p.hn = (u16*)take((size_t)R * D * 2);
  p.y = (u16*)take((size_t)R * D * 2);
  p.h = (u16*)take((size_t)R * DFF * 2);
  { char* q = (char*)p.h; size_t o2 = 0; auto tk = [&](size_t bytes) { char* r = q + o2; o2 += (bytes + 255) & ~(size_t)255; return (u16*)r; };
    p.aq = tk((size_t)R * 384 * 2); p.ak = tk((size_t)R * 384 * 2); p.bq = tk((size_t)R * 384 * 2); p.bk = tk((size_t)R * 128 * 2);
    p.avT = tk((size_t)NB * 6 * 64 * SEQ * 2); p.avTc = tk((size_t)NB * 6 * 64 * CTXL * 2);
    p.bvT = tk((size_t)NB * 2 * 64 * SEQ * 2); p.bvTc = tk((size_t)NB * 2 * 64 * CTXL * 2);
    p.pqT = tk((size_t)NB * 256 * 2 * SEQ * 2); p.pqTc = tk((size_t)NB * 256 * 2 * CTXL * 2);
    if (o2 > (size_t)R * DFF * 2) { fprintf(stderr, "alias overflow\n"); return; } }
  if (off > ws_size) { fprintf(stderr, "workspace too small: need %zu have %zu\n", off, ws_size); return; }

  (void)hipMemsetAsync(p.bar, 0, XCD_BAR_WORDS * 4, stream);
  static int grid_blocks = 0;
  if (!grid_blocks) {
    int dev = 0, cus = 0, per_cu = 0;
    (void)hipGetDevice(&dev);
    (void)hipDeviceGetAttribute(&cus, hipDeviceAttributeMultiprocessorCount, dev);
    (void)hipFuncSetAttribute((const void*)mega_kernel, hipFuncAttributeMaxDynamicSharedMemorySize, LDS_BYTES);
    (void)hipOccupancyMaxActiveBlocksPerMultiprocessor(&per_cu, (const void*)mega_kernel, NTHREADS, LDS_BYTES);
    if (per_cu < 1) fprintf(stderr, "occupancy query says %d blocks/CU\n", per_cu);
    grid_blocks = cus > 0 ? cus : 256;
  }
#if MK_MULTI
  for (int ph = 0; ph < N_PHASES; ++ph)
    hipLaunchKernelGGL(mega_kernel, dim3(grid_blocks), dim3(NTHREADS), LDS_BYTES, stream, p, ph, ph + 1);
#else
  int ph_lo = 0, ph_hi = N_PHASES;
  void* args[] = {&p, &ph_lo, &ph_hi};
  hipError_t e = hipLaunchCooperativeKernel((const void*)mega_kernel, dim3(grid_blocks), dim3(NTHREADS), args, LDS_BYTES, stream);
  if (e != hipSuccess) fprintf(stderr, "cooperative launch failed: %s (grid %d)\n", hipGetErrorString(e), grid_blocks);
#endif
}
```

```cpp
#include <hip/hip_runtime.h>
#include <hip/hip_cooperative_groups.h>
#include <cstdio>
namespace cg = cooperative_groups;

#ifndef PROBE_REP_PH
#define PROBE_REP_PH -1
#endif
#ifndef MK_MULTI
#define MK_MULTI 0
#endif

typedef unsigned short u16;
using bf16x8 = __attribute__((ext_vector_type(8))) short;
using bf16x4 = __attribute__((ext_vector_type(4))) short;
using f32x4  = __attribute__((ext_vector_type(4))) float;
#define DI __device__ __forceinline__

constexpr int D = 1024, NB = 8, SEQ = 4096, CTXL = 256, DFF = 2816, NMOD = 9;
constexpr int NLAT = NB * SEQ;
constexpr int NCTX = NB * CTXL;
constexpr int R = NLAT + NCTX;
constexpr int DIN = 2048, DINX = 2304;
constexpr int NTHREADS = 512;
constexpr float LOG2E = 1.4426950408889634f;
constexpr float QSCALE = 0.125f * LOG2E;

struct Params {
  const float *x, *c, *ctx, *c_ctx, *w_mod, *b_mod, *g_pre, *g_post, *w_ffn_in, *w_ffn_out, *w_in, *w_out, *na_rpb, *swa_sink;
  float *out, *xc, *mod;
  u16 *w1t, *w2t, *wint, *woutt, *dft, *dftc, *h, *hn, *y;
  u16 *aq, *ak, *avT, *avTc, *bq, *bk, *bvT, *bvTc, *pqT, *pqTc, *eo;
  unsigned *ctr, *bar;
};

typedef const __attribute__((address_space(4))) Params* PPtr;
DI int TID() { int t = threadIdx.x; asm volatile("" : "+v"(t)); return t; }
DI PPtr pp_fresh(PPtr p) { asm volatile("" : "+s"(p)); return p; }

typedef __bf16 bf16x2_t __attribute__((ext_vector_type(2)));
DI unsigned pack2(float a, float b) { bf16x2_t v = {(__bf16)a, (__bf16)b}; return __builtin_bit_cast(unsigned, v); }
DI u16 f2bf(float f) { return (u16)(pack2(f, 0.f) & 0xffffu); }
DI float bf2f(u16 h) { return __uint_as_float(((unsigned)h) << 16); }
DI uint2 pack4(f32x4 v) { uint2 w; w.x = pack2(v[0], v[1]); w.y = pack2(v[2], v[3]); return w; }

constexpr int BM = 256, BK = 64, HALF = 128, NXCD = 8, WGM = 8, HT = HALF * BK;
constexpr int GEMM_LDS = 8 * HT * 2;
constexpr int LDS_BYTES = 148480 + 64 + 2048 + 64;
constexpr int XB_ST_OFF = 148480 + 64 + 2048;
constexpr int F_AK = 384, F_BQ = 768, F_BK = 1152, F_AV = 1280, F_BV = 1664, F_P = 1792;

DI int lds_byte(int r, int c) {
  int st = (r >> 4) * 2 + (c >> 5), rr = r & 15, cc = c & 31, ob = rr * 64 + cc * 2;
  return st * 1024 + (ob ^ (((ob >> 9) & 1) << 5));
}
DI void stage_rc(int b, int& Rr, int& Cc) {
  int st = b / 1024, sb = b % 1024, swz = sb ^ (((sb >> 9) & 1) << 5);
  Rr = (st >> 1) * 16 + swz / 64; Cc = (st & 1) * 32 + (swz % 64) / 2;
}
DI void tile_coords(int w, int nM, int nN, int& pm, int& pn) {
  int nwg = nM * nN, q = nwg / NXCD, r = nwg % NXCD, xcd = w % NXCD, off = w / NXCD;
  int id = (xcd < r ? xcd * (q + 1) : r * (q + 1) + (xcd - r) * q) + off;
  int nig = WGM * nN, gid = id / nig, fm = gid * WGM, gsz = min(nM - fm, WGM);
  pm = fm + ((id % nig) % gsz); pn = (id % nig) / gsz;
}

struct Tile { const u16* A; const u16* Bt; u16* C; int K, brow, bcol, kind, ldc, dep  ; };
struct GemmDesc { const u16* A; const u16* Bt; u16* C; int M, N, K, kind, ldc, mode, ntiles; const u16* B2; unsigned* ctr; };

DI Tile tile_of(PPtr p, const GemmDesc& g, int w) {
  Tile t; t.A = g.A; t.Bt = g.Bt; t.C = g.C; t.K = g.K; t.kind = g.kind; t.ldc = g.ldc; t.dep = 0;
  if (g.mode == 1) {
    if (w < 128) { const int b = w >> 4, kb = (w & 15) >> 1, which = w & 1;
      t.A = p->dft + (size_t)which * 2048 * 4096; t.Bt = p->pqT + (size_t)which * (NB * 256 * SEQ) + (size_t)b * 256 * SEQ;
      t.brow = kb * 256; t.bcol = 0; t.C = p->eo + ((size_t)(which * NB + b) * 2048) * 256; t.ldc = 256; }
    else { int b = w - 128; t.A = p->dftc; t.Bt = p->pqTc + (size_t)b * 256 * 512; t.K = 512; t.brow = 0; t.bcol = 0; t.C = p->hn + (size_t)(NLAT + b * CTXL) * D + 768; }
  } else if (g.mode == 2) {
    int pm, pn;
    if (w < 136 * 5) { tile_coords(w, 136, 5, pm, pn); t.brow = pm * BM; t.bcol = pn * BM; t.kind = 2; }
    else { tile_coords(w - 136 * 5, 136, 4, pm, pn); t.A = g.Bt; t.Bt = g.A; t.brow = F_AV + pn * BM; t.bcol = pm * BM; t.kind = 3; }
  } else if (g.mode == 3) {
    const int nM = R / BM, nN = 2 * DFF / BM, nreg = nM * nN;
    if (w < nreg) { int pm, pn; tile_coords(w, nM, nN, pm, pn); pm = nM - 1 - pm; t.brow = pm * BM; t.bcol = pn * BM; t.dep = (pm >= NLAT / BM) ? 1 : 0; }
    else { const int j = w - nreg; t.A = p->h; t.Bt = g.B2; t.C = p->y; t.K = DFF; t.kind = 0; t.ldc = D; t.brow = NLAT + (j >> 2) * BM; t.bcol = (j & 3) * BM; t.dep = 2; }
  } else { int pm, pn; tile_coords(w, g.M / BM, g.N / BM, pm, pn); t.brow = pm * BM; t.bcol = pn * BM; }
  return t;
}

DI int stg_off(int rl, int bo) { return rl * 512 + ((((bo >> 4) ^ rl) & 31) << 4) + (bo & 15); }

DI void epi_staged(PPtr p, const Tile& T, const f32x4 (&acc)[2][2][4][2], char* stg, int tid) {
  const int wid = tid >> 6, lane = tid & 63, wr = wid >> 2, wc = wid & 3, fr = lane & 15, fq = lane >> 4;
  const int kind = T.kind;
  const bool lat2 = T.brow < NLAT;
  if (kind == 1) {
    _Pragma("unroll") for (int ai = 0; ai < 2; ++ai) _Pragma("unroll") for (int bj = 0; bj < 2; ++bj) _Pragma("unroll") for (int m = 0; m < 4; ++m) {
      const int rl = ai * HALF + wr * 64 + m * 16 + fr, bo = (bj * 64 + wc * 16 + fq * 4) * 2;
      const f32x4 v0 = acc[ai][bj][m][0], v1 = acc[ai][bj][m][1]; f32x4 h;
      _Pragma("unroll") for (int j = 0; j < 4; ++j) h[j] = v0[j] * __builtin_amdgcn_rcpf(1.f + __expf(-v0[j])) * v1[j];
      *(uint2*)(stg + rl * 256 + ((((bo >> 4) ^ rl) & 15) << 4) + (bo & 15)) = pack4(h);
    }
    asm volatile("s_waitcnt lgkmcnt(0)" ::: "memory"); __builtin_amdgcn_s_barrier();
    _Pragma("unroll") for (int i = 0; i < 8; ++i) {
      const int q = tid + i * NTHREADS, rl = q >> 4, cc = q & 15;
      const uint4 v = *(const uint4*)(stg + rl * 256 + (((cc ^ rl) & 15) << 4));
      u16* d = T.C + (size_t)(T.brow + rl) * DFF + (T.bcol >> 1) + cc * 8;
      if (T.dep == 1) {
        __hip_atomic_store((unsigned long long*)d, ((unsigned long long)v.y << 32) | v.x, __ATOMIC_RELAXED, __HIP_MEMORY_SCOPE_AGENT);
        __hip_atomic_store((unsigned long long*)d + 1, ((unsigned long long)v.w << 32) | v.z, __ATOMIC_RELAXED, __HIP_MEMORY_SCOPE_AGENT);
      }
      else *(uint4*)d = v;
    }
    asm volatile("s_waitcnt lgkmcnt(0)" ::: "memory"); __builtin_amdgcn_s_barrier();
    return;
  }
  _Pragma("unroll") for (int ai = 0; ai < 2; ++ai) {
    _Pragma("unroll") for (int bj = 0; bj < 2; ++bj) {
      const int gc = T.bcol + bj * HALF + wc * 32;
      float inv[4];
      const bool rope = (kind == 2) && (gc >= F_BQ) && lat2;
      if (rope) { _Pragma("unroll") for (int j = 0; j < 4; ++j) inv[j] = exp2f(-(float)(fq * 4 + j) * (13.287712379549449f / 16.f)); }
      _Pragma("unroll") for (int m = 0; m < 4; ++m) {
        const int rl = wr * 64 + m * 16 + fr;
        f32x4 v0 = acc[ai][bj][m][0], v1 = acc[ai][bj][m][1];
        if (kind == 1) {
          f32x4 h;
          _Pragma("unroll") for (int j = 0; j < 4; ++j) h[j] = v0[j] * __builtin_amdgcn_rcpf(1.f + __expf(-v0[j])) * v1[j];
          *(uint2*)(stg + stg_off(rl, (bj * 64 + wc * 16 + fq * 4) * 2)) = pack4(h);
        } else {
          if (rope) {
            const int s = (T.brow + ai * HALF + rl) & 4095; const float pos = (float)((gc & 32) ? (s & 63) : (s >> 6));
            _Pragma("unroll") for (int j = 0; j < 4; ++j) {
              const float ang = pos * inv[j], cs = __cosf(ang), sn = __sinf(ang), x1 = v0[j], x2 = v1[j];
              v0[j] = x1 * cs - x2 * sn; v1[j] = x1 * sn + x2 * cs;
            }
          }
          const int bo = (bj * HALF + wc * 32 + fq * 4) * 2;
          *(uint2*)(stg + stg_off(rl, bo)) = pack4(v0);
          *(uint2*)(stg + stg_off(rl, bo + 32)) = pack4(v1);
        }
      }
    }
    asm volatile("s_waitcnt lgkmcnt(0)" ::: "memory"); __builtin_amdgcn_s_barrier();
    if (kind == 1) {
      _Pragma("unroll") for (int i = 0; i < 4; ++i) {
        const int q = tid + i * NTHREADS, rl = q >> 4, cc = q & 15;
        const uint4 v = *(const uint4*)(stg + stg_off(rl, cc * 16));
        u16* d = T.C + (size_t)(T.brow + ai * HALF + rl) * DFF + (T.bcol >> 1) + cc * 8;
        if (T.dep == 1) {
          __hip_atomic_store((unsigned long long*)d, ((unsigned long long)v.y << 32) | v.x, __ATOMIC_RELAXED, __HIP_MEMORY_SCOPE_AGENT);
          __hip_atomic_store((unsigned long long*)d + 1, ((unsigned long long)v.w << 32) | v.z, __ATOMIC_RELAXED, __HIP_MEMORY_SCOPE_AGENT);
        }
        else *(uint4*)d = v;
      }
    } else {
      _Pragma("unroll") for (int i = 0; i < 8; ++i) {
        const int q = tid + i * NTHREADS, rl = q >> 5, cc = q & 31;
        const uint4 v = *(const uint4*)(stg + stg_off(rl, cc * 16));
        const int r = T.brow + ai * HALF + rl, c = T.bcol + cc * 8;
        u16* d;
        if (kind == 0) d = T.C + (size_t)r * T.ldc + c;
        else if (kind == 2) {
          d = (c < F_AK) ? p->aq + (size_t)r * 384 + c : (c < F_BQ) ? p->ak + (size_t)r * 384 + (c - F_AK)
            : (c < F_BK) ? p->bq + (size_t)r * 384 + (c - F_BQ) : p->bk + (size_t)r * 128 + (c - F_BK);
        } else {
          const bool lat = T.bcol < NLAT;
          const int b = lat ? (c >> 12) : ((c - NLAT) >> 8), s0 = lat ? (c & 4095) : ((c - NLAT) & 255);
          if (r < F_BV)     d = lat ? p->avT + ((size_t)b * 384 + (r - F_AV)) * SEQ + s0 : p->avTc + ((size_t)b * 384 + (r - F_AV)) * CTXL + s0;
          else if (r < F_P) d = lat ? p->bvT + ((size_t)b * 128 + (r - F_BV)) * SEQ + s0 : p->bvTc + ((size_t)b * 128 + (r - F_BV)) * CTXL + s0;
          else { const int ch = r - F_P, which = ch >> 8, cq = ch & 255;
                 d = lat ? p->pqT + (size_t)which * (NB * 256 * SEQ) + ((size_t)b * 256 + cq) * SEQ + s0 : p->pqTc + ((size_t)b * 256 + cq) * (2 * CTXL) + which * CTXL + s0; }
        }
        *(uint4*)d = v;
      }
    }
    asm volatile("s_waitcnt lgkmcnt(0)" ::: "memory"); __builtin_amdgcn_s_barrier();
  }
}

DI void gemm_run(u16* shm, PPtr p, const GemmDesc& g) {
#define SA(b, h) (shm + ((b) * 4 + (h)) * HT)
#define SB(b, h) (shm + ((b) * 4 + 2 + (h)) * HT)
#define STAGE(P, BASE, br, kt) do { unsigned long long _ga = (unsigned long long)((BASE) + (long)(br) * K + (long)(kt) * BK); \
    asm volatile("" : "+s"(_ga)); const char* _gb = (const char*)_ga; \
    __builtin_amdgcn_global_load_lds((const unsigned*)(_gb + voff0), (__attribute__((address_space(3))) unsigned*)((char*)(P) + tid * 16), 16, 0, 0); \
    __builtin_amdgcn_global_load_lds((const unsigned*)(_gb + voff1), (__attribute__((address_space(3))) unsigned*)((char*)(P) + tid * 16 + 8192), 16, 0, 0); } while (0)
#define LDA(dst, b, h) for (int m = 0; m < 4; ++m) for (int k = 0; k < 2; ++k) \
    dst[m][k] = *reinterpret_cast<const bf16x8*>((char*)SA(b, h) + lds_byte(wr * 64 + m * 16 + fr, k * 32 + fq * 8))
#define LDB(dst, b, h) for (int n = 0; n < 2; ++n) for (int k = 0; k < 2; ++k) \
    dst[n][k] = *reinterpret_cast<const bf16x8*>((char*)SB(b, h) + lds_byte(wc * 32 + n * 16 + fr, k * 32 + fq * 8))
#define MMA(ai, bj, At_, Bt_) do { __builtin_amdgcn_s_setprio(1); \
    for (int m = 0; m < 4; ++m) for (int n = 0; n < 2; ++n) for (int k = 0; k < 2; ++k) \
      acc[ai][bj][m][n] = __builtin_amdgcn_mfma_f32_16x16x32_bf16(Bt_[n][k], At_[m][k], acc[ai][bj][m][n], 0, 0, 0); \
    __builtin_amdgcn_s_setprio(0); } while (0)
#define WAIT_V(n) asm volatile("s_waitcnt vmcnt(" #n ")" ::: "memory")
#define WAIT_L(n) asm volatile("s_waitcnt lgkmcnt(" #n ")" ::: "memory")
#define BAR __builtin_amdgcn_s_barrier()
#define SCHED __builtin_amdgcn_sched_barrier(0)
#define SET_VOFF(KK) do { int _r, _c; stage_rc(tid * 16, _r, _c); voff0 = (unsigned)(_r * (KK) + _c) * 2u; \
    stage_rc(tid * 16 + 8192, _r, _c); voff1 = (unsigned)(_r * (KK) + _c) * 2u; } while (0)
#define ISSUE_FIRST() do { STAGE(SB(0, 0), Bt, bcol, 0); STAGE(SA(0, 0), A, brow, 0); STAGE(SB(0, 1), Bt, bcol + HALF, 0); STAGE(SA(0, 1), A, brow + HALF, 0); } while (0)
#define NEXT_W(it) ((g.mode != 3 || gridDim.x != 256) ? (((int)blockIdx.x + (it) * (int)gridDim.x < g.ntiles) ? (int)blockIdx.x + (it) * (int)gridDim.x : -1) \
    : ((int)blockIdx.x < 224 ? (((int)blockIdx.x + (it) * 224 < 2672) ? (int)blockIdx.x + (it) * 224 : -1) \
       : ((it) < 10 ? 2672 + ((int)blockIdx.x - 224) + (it) * 32 : ((it) == 10 ? 2992 + ((int)blockIdx.x - 224) : -1))))
  int it_ = 0;
  int w = NEXT_W(0);
  if (w < 0) return;
  const int tid = TID();
  const int wid = tid >> 6, lane = tid & 63, wr = wid >> 2, wc = wid & 3, fr = lane & 15, fq = lane >> 4;
#define DEP_WAIT() do { if (tid == 0) { while (__hip_atomic_load(g.ctr, __ATOMIC_RELAXED, __HIP_MEMORY_SCOPE_AGENT) < (unsigned)((NCTX / BM) * (2 * DFF / BM))) __builtin_amdgcn_s_sleep(16); } \
    __syncthreads(); __builtin_amdgcn_fence(__ATOMIC_ACQUIRE, "agent"); } while (0)
  Tile T = tile_of(p, g, w);
  const u16 *A = T.A, *Bt = T.Bt; int K = T.K, brow = T.brow, bcol = T.bcol;
  unsigned voff0, voff1;
  SET_VOFF(K);
  if (T.dep == 2) DEP_WAIT();
  ISSUE_FIRST();
#pragma unroll 1
  for (;;) {
    f32x4 acc[2][2][4][2] = {};
    bf16x8 At[4][2], B0[2][2], B1[2][2];
    const int nt = K / BK;
    if (wr == 1) BAR;
    WAIT_V(0); BAR;
    STAGE(SB(1, 0), Bt, bcol, 1); STAGE(SA(1, 0), A, brow, 1); STAGE(SB(1, 1), Bt, bcol + HALF, 1);
    WAIT_V(6); BAR;
    for (int t = 0; t < nt - 2; t += 2) {
      LDB(B0, 0, 0); SCHED; LDA(At, 0, 0); STAGE(SA(1, 1), A, brow + HALF, t + 1);
      WAIT_L(8); BAR; WAIT_L(0); MMA(0, 0, At, B0); BAR; SCHED;
      LDB(B1, 0, 1); STAGE(SB(0, 0), Bt, bcol, t + 2);
      BAR; WAIT_L(0); MMA(0, 1, At, B1); BAR;
      LDA(At, 0, 1); STAGE(SA(0, 0), A, brow, t + 2);
      BAR; WAIT_L(0); MMA(1, 0, At, B0); BAR; SCHED;
      STAGE(SB(0, 1), Bt, bcol + HALF, t + 2);
      WAIT_V(6); BAR; MMA(1, 1, At, B1); BAR;
      LDB(B0, 1, 0); SCHED; LDA(At, 1, 0); STAGE(SA(0, 1), A, brow + HALF, t + 2);
      WAIT_L(8); BAR; WAIT_L(0); MMA(0, 0, At, B0); BAR; SCHED;
      LDB(B1, 1, 1); STAGE(SB(1, 0), Bt, bcol, t + 3);
      BAR; WAIT_L(0); MMA(0, 1, At, B1); BAR;
      LDA(At, 1, 1); STAGE(SA(1, 0), A, brow, t + 3);
      BAR; WAIT_L(0); MMA(1, 0, At, B0); BAR; SCHED;
      STAGE(SB(1, 1), Bt, bcol + HALF, t + 3);
      WAIT_V(6); BAR; MMA(1, 1, At, B1); BAR;
    }
    { LDB(B0, 0, 0); LDA(At, 0, 0); STAGE(SA(1, 1), A, brow + HALF, nt - 1);
      BAR; WAIT_L(0); MMA(0, 0, At, B0); BAR;
      LDB(B1, 0, 1); BAR; WAIT_L(0); MMA(0, 1, At, B1); BAR;
      LDA(At, 0, 1); WAIT_V(4); BAR; WAIT_L(0); MMA(1, 0, At, B0); MMA(1, 1, At, B1); BAR; }
    { LDB(B0, 1, 0); LDA(At, 1, 0); WAIT_V(2); BAR; WAIT_L(0); MMA(0, 0, At, B0); BAR;
      LDB(B1, 1, 1); WAIT_V(0); BAR; WAIT_L(0); MMA(0, 1, At, B1); BAR;
      LDA(At, 1, 1); BAR; WAIT_L(0); MMA(1, 0, At, B0); MMA(1, 1, At, B1); BAR; }
    if (wr == 0) BAR;
    const Tile Tc = T;
    ++it_; w = NEXT_W(it_);
    const bool more = w >= 0;
    if (more) {
      T = tile_of(p, g, w); A = T.A; Bt = T.Bt; brow = T.brow; bcol = T.bcol;
      if (T.K != K) { K = T.K; SET_VOFF(K); }
      if (T.dep == 2) DEP_WAIT();
      ISSUE_FIRST();
    }
    epi_staged(pp_fresh(p), Tc, acc, (char*)shm + 65536, TID());
    if (Tc.dep == 1) {
      asm volatile("s_waitcnt vmcnt(0)" ::: "memory"); __syncthreads();
      if (tid == 0) __hip_atomic_fetch_add(g.ctr, 1u, __ATOMIC_RELAXED, __HIP_MEMORY_SCOPE_AGENT);
    }
    if (!more) break;
  }
#undef SA
#undef SB
#undef STAGE
#undef LDA
#undef LDB
#undef MMA
#undef SET_VOFF
#undef ISSUE_FIRST
#undef DEP_WAIT
#undef NEXT_W
}

DI int ffn_src_col(int n) { int blk = n >> 5, t = n & 31; return t < 16 ? blk * 16 + t : DFF + blk * 16 + (t - 16); }

DI void transpose_tile4(float* tl, const float* src, int ld_src, u16* dst, int Kd, int k0, int n0, int mode) {
  const int tid = TID();
  float v[4][8]; float sc[4];
  { const int nn = tid & 63, kb = tid >> 6;
    _Pragma("unroll") for (int sub = 0; sub < 4; ++sub) {
      const int n = n0 + sub * 64;
      int col; sc[sub] = 1.f;
      if (mode == 1) col = ffn_src_col(n + nn);
      else if (mode == 2) { const int coloff = (n < F_BQ) ? 0 : (n < F_AV) ? (1152 - F_BQ) : (n < F_BV) ? (768 - F_AV) : 0; col = n + nn + coloff;
                            sc[sub] = (n < F_AK || (n >= F_BQ && n < F_BK)) ? QSCALE : 1.f; }
      else col = n + nn;
      _Pragma("unroll") for (int i = 0; i < 8; ++i) v[sub][i] = src[(size_t)(k0 + kb + 8 * i) * ld_src + col];
    }
    _Pragma("unroll") for (int sub = 0; sub < 4; ++sub) _Pragma("unroll") for (int i = 0; i < 8; ++i) tl[sub * (64 * 65) + (kb + 8 * i) * 65 + nn] = v[sub][i] * sc[sub];
  }
  __syncthreads();
  { const int kk = (tid & 31) * 2, nb = tid >> 5;
    _Pragma("unroll") for (int sub = 0; sub < 4; ++sub) _Pragma("unroll") for (int i = 0; i < 4; ++i) { const int nn = nb + 16 * i;
      *(unsigned*)(dst + (size_t)(n0 + sub * 64 + nn) * Kd + k0 + kk) = pack2(tl[sub * (64 * 65) + kk * 65 + nn], tl[sub * (64 * 65) + (kk + 1) * 65 + nn]); } }
  __syncthreads();
}

DI void phase_prep(PPtr p, char* shmc) {
  float* tl = (float*)shmc;
  const int tid = TID();
  if (blockIdx.x == 0 && tid < 32) p->ctr[tid] = 0u;
  constexpr int N_W1 = 2 * 2 * 22 * 16, N_W2 = 2 * 2 * 4 * 44, N_WI = 2 * 7 * 16, N_WO = 2 * 4 * 16, N_FOLD = 2 * 4 * 16;
  constexpr int N_DFT = 4096, N_DFTC = 256, N_GEMV = 2 * 144;
  constexpr int O_W2 = N_W1, O_WI = O_W2 + N_W2, O_WO = O_WI + N_WI, O_FOLD = O_WO + N_WO, O_DFT = O_FOLD + N_FOLD, O_DFTC = O_DFT + N_DFT,
                O_GEMV = O_DFTC + N_DFTC, N_TOT = O_GEMV + N_GEMV;
#pragma unroll 1
  for (int it0 = blockIdx.x; it0 < N_TOT; it0 += gridDim.x) {
    int it = N_TOT - 1 - it0;
    if (it < O_W2) {
      int lf = it / (22 * 16), rem = it % (22 * 16), nt = rem / 16, kt = rem % 16;
      transpose_tile4(tl, p->w_ffn_in + (size_t)lf * D * 2 * DFF, 2 * DFF, p->w1t + (size_t)lf * 2 * DFF * D, D, kt * 64, nt * 256, 1);
    } else if (it < O_WI) {
      int i2 = it - O_W2; int lf = i2 / (4 * 44), rem = i2 % (4 * 44), nt = rem / 44, kt = rem % 44;
      transpose_tile4(tl, p->w_ffn_out + (size_t)lf * DFF * D, D, p->w2t + (size_t)lf * D * DFF, DFF, kt * 64, nt * 256, 0);
    } else if (it < O_WO) {
      int i2 = it - O_WI; int l = i2 / (7 * 16), rem = i2 % (7 * 16), nt = rem / 16, kt = rem % 16;
      transpose_tile4(tl, p->w_in + (size_t)l * D * DIN, DIN, p->wint + (size_t)l * DINX * D, D, kt * 64, nt * 256, 2);
    } else if (it < O_FOLD) {
      int i2 = it - O_WO; int l = i2 / 64, rem = i2 % 64, nt = rem / 16, kt = rem % 16;
      transpose_tile4(tl, p->w_out + (size_t)l * D * D, D, p->woutt + (size_t)l * D * D, D, kt * 64, nt * 256, 0);
    } else if (it < O_DFT) {
      int i2 = it - O_FOLD; int l = i2 / 64, g = (i2 % 64) / 16, kt = i2 % 16, k0 = kt * 64;
      float* twc = tl + 64 * 65; float* tws = twc + 64;
      { int nn = tid & 63, kb = tid >> 6;
        for (int i = 0; i < 8; ++i) { int kk = kb + 8 * i; tl[kk * 65 + nn] = p->w_in[(size_t)l * D * DIN + (size_t)(k0 + kk) * DIN + 1792 + g * 64 + nn]; } }
      if (tid < 64) { twc[tid] = cospif((float)tid / 32.f); tws[tid] = sinpif((float)tid / 32.f); }
      __syncthreads();
      { int kk = tid & 63, mg = tid >> 6;
#pragma unroll 1
        for (int i = 0; i < 16; ++i) {
          int mo = mg * 16 + i, which = mo >> 6, m = mo & 63;
          const float* tw = which ? tws : twc;
          float s = 0.f;
#pragma unroll 4
          for (int c = 0; c < 64; ++c) s += tl[kk * 65 + c] * tw[(m * c) & 63];
          p->wint[(size_t)l * DINX * D + (size_t)(1792 + which * 256 + g * 64 + m) * D + k0 + kk] = f2bf(s);
        } }
      __syncthreads();
    } else if (it < O_DFTC) {
      const int k = (it - O_DFT) & 2047, which = (it - O_DFT) >> 11;
      const int col0 = tid * 8; unsigned w[4];
      for (int e = 0; e < 4; ++e) {
        float v[2];
        for (int q = 0; q < 2; ++q) { const int n = col0 + e * 2 + q; const int j = (k * n) & 4095; const float a = (float)j / 2048.f;
          v[q] = (which ? sinpif(a) : cospif(a)) * (1.f / 512.f); }
        w[e] = pack2(v[0], v[1]);
      }
      uint4 o; o.x = w[0]; o.y = w[1]; o.z = w[2]; o.w = w[3];
      *(uint4*)(p->dft + ((size_t)which * 2048 + k) * 4096 + col0) = o;
    } else if (it < O_GEMV) {
      int k = it - O_DFTC; int col = tid; int n = col & 255; int j = (k * n) & 255; float a = (float)j / 128.f;
      float v = (col < 256) ? cospif(a) * (1.f / 128.f) : -sinpif(a) * (1.f / 128.f);
      p->dftc[k * 512 + col] = f2bf(v);
    } else {
      int i2 = it - O_GEMV; int l = i2 / 144, n0 = (i2 % 144) * 64;
      float* act = tl;
      float* red = tl + 1024 * 12;
      for (int e = tid; e < 9 * 1024; e += NTHREADS) {
        int bb = e >> 10, k = e & 1023; float v = (bb < 8) ? p->c[bb * D + k] : p->c_ctx[k];
        act[k * 12 + bb] = v / (1.f + __expf(-v));
      }
      __syncthreads();
      int col = tid & 63, kg = tid >> 6;
      float a[9]; for (int q = 0; q < 9; ++q) a[q] = 0.f;
      const float* wp = p->w_mod + (size_t)l * D * (NMOD * D) + n0 + col;
#pragma unroll 1
      for (int k0 = kg * 128; k0 < kg * 128 + 128; k0 += 16) {
        float wv[16];
        _Pragma("unroll") for (int j = 0; j < 16; ++j) wv[j] = wp[(size_t)(k0 + j) * (NMOD * D)];
        _Pragma("unroll") for (int j = 0; j < 16; ++j) {
          const int k = k0 + j; const float w = wv[j];
          f32x4 a0 = *(const f32x4*)(act + k * 12), a1 = *(const f32x4*)(act + k * 12 + 4); float a8 = act[k * 12 + 8];
          a[0] += a0[0] * w; a[1] += a0[1] * w; a[2] += a0[2] * w; a[3] += a0[3] * w;
          a[4] += a1[0] * w; a[5] += a1[1] * w; a[6] += a1[2] * w; a[7] += a1[3] * w; a[8] += a8 * w;
        }
      }
      for (int q = 0; q < 9; ++q) red[(kg * 9 + q) * 64 + col] = a[q];
      __syncthreads();
      for (int e = tid; e < 9 * 64; e += NTHREADS) {
        int q = e >> 6, cc = e & 63; float s = 0.f;
        for (int g = 0; g < 8; ++g) s += red[(g * 9 + q) * 64 + cc];
        p->mod[((size_t)l * 9 + q) * (NMOD * D) + n0 + cc] = s + p->b_mod[(size_t)l * (NMOD * D) + n0 + cc];
      }
      __syncthreads();
    }
  }
}

DI float wave_sum(float v) { for (int o = 32; o > 0; o >>= 1) v += __shfl_xor(v, o); return v; }

template <int RPW>
DI void norm_rows(PPtr p, int row0, int lane, int lp, int sp, int ln, int sn, bool first) {
  {
    const bool lat = row0 < NLAT; const int bidx = lat ? (row0 >> 12) : 8;
    const float* xin; float* xout;
    if (lat) { xout = p->out + (size_t)row0 * D; xin = first ? p->x + (size_t)row0 * D : xout; }
    else     { xout = p->xc + (size_t)(row0 - NLAT) * D; xin = first ? p->ctx + (size_t)(row0 - NLAT) * D : xout; }
    f32x4 xv[RPW][4]; uint2 yw[RPW][4];
    _Pragma("unroll") for (int r = 0; r < RPW; ++r) _Pragma("unroll") for (int i = 0; i < 4; ++i) xv[r][i] = *(const f32x4*)(xin + (size_t)r * D + i * 256 + lane * 4);
    if (sp >= 0) {
      _Pragma("unroll") for (int r = 0; r < RPW; ++r) _Pragma("unroll") for (int i = 0; i < 4; ++i) yw[r][i] = *(const uint2*)(p->y + (size_t)(row0 + r) * D + i * 256 + lane * 4);
      const float wgt = (sp == 1) ? 1.f : 0.5f;
      const float* gate = p->mod + ((size_t)lp * 9 + bidx) * (NMOD * D) + (3 * sp + 2) * D;
      const float* gp = p->g_post + ((size_t)lp * 3 + sp) * D;
      f32x4 gg[4];
      _Pragma("unroll") for (int i = 0; i < 4; ++i) { f32x4 g = *(const f32x4*)(gate + i * 256 + lane * 4), q = *(const f32x4*)(gp + i * 256 + lane * 4); gg[i] = g * q * wgt; }
      _Pragma("unroll") for (int r = 0; r < RPW; ++r) {
        f32x4 yv[4]; float ss = 0.f;
        _Pragma("unroll") for (int i = 0; i < 4; ++i) {
          yv[i][0] = __uint_as_float(yw[r][i].x << 16); yv[i][1] = __uint_as_float(yw[r][i].x & 0xffff0000u);
          yv[i][2] = __uint_as_float(yw[r][i].y << 16); yv[i][3] = __uint_as_float(yw[r][i].y & 0xffff0000u);
          _Pragma("unroll") for (int j = 0; j < 4; ++j) ss += yv[i][j] * yv[i][j];
        }
        ss = wave_sum(ss);
        const float rr = rsqrtf(ss * (1.f / D) + 1e-6f);
        _Pragma("unroll") for (int i = 0; i < 4; ++i) {
          _Pragma("unroll") for (int j = 0; j < 4; ++j) xv[r][i][j] += gg[i][j] * (yv[i][j] * rr);
          *(f32x4*)(xout + (size_t)r * D + i * 256 + lane * 4) = xv[r][i];
        }
      }
    }
    if (sn >= 0) {
      const float* sh = p->mod + ((size_t)ln * 9 + bidx) * (NMOD * D) + (3 * sn) * D;
      const float* sc = sh + D;
      const float* gq = p->g_pre + ((size_t)ln * 3 + sn) * D;
      f32x4 ma[4], mb[4];
      _Pragma("unroll") for (int i = 0; i < 4; ++i) {
        f32x4 a = *(const f32x4*)(sh + i * 256 + lane * 4), bb = *(const f32x4*)(sc + i * 256 + lane * 4), q = *(const f32x4*)(gq + i * 256 + lane * 4);
        ma[i] = q * (1.f + bb); mb[i] = a;
      }
      _Pragma("unroll") for (int r = 0; r < RPW; ++r) {
        float ss = 0.f;
        _Pragma("unroll") for (int i = 0; i < 4; ++i) _Pragma("unroll") for (int j = 0; j < 4; ++j) ss += xv[r][i][j] * xv[r][i][j];
        ss = wave_sum(ss);
        const float rr = rsqrtf(ss * (1.f / D) + 1e-6f);
        _Pragma("unroll") for (int i = 0; i < 4; ++i) {
          f32x4 ov = (xv[r][i] * rr) * ma[i] + mb[i];
          *(uint2*)(p->hn + (size_t)(row0 + r) * D + i * 256 + lane * 4) = pack4(ov);
        }
      }
    }
  }
}

DI void phase_norm(PPtr p, int M, int lp, int sp, int ln, int sn, bool first) {
  const int tid = TID(); const int lane = tid & 63;
  const int gw = blockIdx.x * (NTHREADS / 64) + (tid >> 6), nw = gridDim.x * (NTHREADS / 64);
  const int main_rows = (M / (nw * 4)) * (nw * 4);
#pragma unroll 1
  for (int row0 = gw * 4; row0 < main_rows; row0 += nw * 4) norm_rows<4>(p, row0, lane, lp, sp, ln, sn, first);
#pragma unroll 1
  for (int row0 = main_rows + gw; row0 < M; row0 += nw) norm_rows<1>(p, row0, lane, lp, sp, ln, sn, first);
}

struct AttnSt { f32x4 o[4]; float m, l; };
DI float ex2(float x) { return __builtin_amdgcn_exp2f(x); }
DI f32x4 mfma16(bf16x8 a, bf16x8 b, f32x4 c) { return __builtin_amdgcn_mfma_f32_16x16x32_bf16(a, b, c, 0, 0, 0); }
constexpr int ATT_K_BYTES = 576 * 128;
constexpr int ATT_V_BYTES = 64 * (576 * 2 + 16);
constexpr int ATT_LDS = ATT_K_BYTES + ATT_V_BYTES;

template <int NK>
DI void attn_fill(char* lds, const u16* kg, int ldk, const u16* vg, int ldv, int tid) {
  constexpr int PV = NK * 2 + 16, NCH = NK * 8 / NTHREADS;
  uint4 kr[NCH], vr[NCH];
  _Pragma("unroll") for (int i = 0; i < NCH; ++i) { const int id = tid + i * NTHREADS, key = id >> 3, c = id & 7;
    kr[i] = *(const uint4*)(kg + (size_t)key * ldk + c * 8); }
  _Pragma("unroll") for (int i = 0; i < NCH; ++i) { const int id = tid + i * NTHREADS, dim = id / (NK / 8), cc = id % (NK / 8);
    vr[i] = *(const uint4*)(vg + (size_t)dim * ldv + cc * 8); }
  _Pragma("unroll") for (int i = 0; i < NCH; ++i) { const int id = tid + i * NTHREADS, key = id >> 3, c = id & 7;
    *(uint4*)(lds + key * 128 + ((c ^ (key & 7)) << 4)) = kr[i]; }
  _Pragma("unroll") for (int i = 0; i < NCH; ++i) { const int id = tid + i * NTHREADS, dim = id / (NK / 8), cc = id % (NK / 8);
    *(uint4*)(lds + ATT_K_BYTES + dim * PV + cc * 16) = vr[i]; }
}

DI void lds_qk(const char* lds, int kk0, int kk1, int quad, bf16x8 q0, bf16x8 q1, f32x4& s0, f32x4& s1) {
  const char* r0 = lds + kk0 * 128; const char* r1 = lds + kk1 * 128;
  const bf16x8 k00 = *(const bf16x8*)(r0 + ((quad ^ (kk0 & 7)) << 4)), k01 = *(const bf16x8*)(r0 + (((4 + quad) ^ (kk0 & 7)) << 4));
  const bf16x8 k10 = *(const bf16x8*)(r1 + ((quad ^ (kk1 & 7)) << 4)), k11 = *(const bf16x8*)(r1 + (((4 + quad) ^ (kk1 & 7)) << 4));
  const f32x4 z = {0.f, 0.f, 0.f, 0.f};
  s0 = mfma16(k00, q0, z); s0 = mfma16(k01, q1, s0);
  s1 = mfma16(k10, q0, z); s1 = mfma16(k11, q1, s1);
}
DI void lds_pv(AttnSt& st, f32x4 s0, f32x4 s1, const char* lds, int pv, int fr, int kv0, int kv1) {
  float mx = fmaxf(fmaxf(fmaxf(s0[0], s0[1]), fmaxf(s0[2], s0[3])), fmaxf(fmaxf(s1[0], s1[1]), fmaxf(s1[2], s1[3])));
  mx = fmaxf(mx, __shfl_xor(mx, 16)); mx = fmaxf(mx, __shfl_xor(mx, 32));
  const float mn = fmaxf(st.m, mx), alpha = ex2(st.m - mn);
  st.m = mn;
  f32x4 p0, p1; float ls = 0.f;
  _Pragma("unroll") for (int j = 0; j < 4; ++j) { p0[j] = ex2(s0[j] - mn); p1[j] = ex2(s1[j] - mn); ls += p0[j] + p1[j]; }
  st.l = st.l * alpha + ls;
  union { bf16x8 v; uint2 h[2]; } pf; pf.h[0] = pack4(p0); pf.h[1] = pack4(p1);
  const char* vb = lds + ATT_K_BYTES + fr * pv;
  _Pragma("unroll") for (int dt = 0; dt < 4; ++dt) {
    union { bf16x8 v; uint2 h[2]; } vf;
    vf.h[0] = *(const uint2*)(vb + dt * 16 * pv + kv0 * 2); vf.h[1] = *(const uint2*)(vb + dt * 16 * pv + kv1 * 2);
    st.o[dt] *= alpha;
    st.o[dt] = mfma16(vf.v, pf.v, st.o[dt]);
  }
}

DI void lds_qk2(const char* kA, const char* kB, int koff, bf16x8 q0, bf16x8 q1, f32x4& s0, f32x4& s1) {
  const bf16x8 k00 = *(const bf16x8*)(kA + koff), k01 = *(const bf16x8*)(kB + koff);
  const bf16x8 k10 = *(const bf16x8*)(kA + koff + 2048), k11 = *(const bf16x8*)(kB + koff + 2048);
  const f32x4 z = {0.f, 0.f, 0.f, 0.f};
  s0 = mfma16(k00, q0, z); s0 = mfma16(k01, q1, s0);
  s1 = mfma16(k10, q0, z); s1 = mfma16(k11, q1, s1);
}
template <int PV>
DI void lds_pv2(AttnSt& st, f32x4 s0, f32x4 s1, const char* vB, int voff) {
  float mx = fmaxf(fmaxf(fmaxf(s0[0], s0[1]), fmaxf(s0[2], s0[3])), fmaxf(fmaxf(s1[0], s1[1]), fmaxf(s1[2], s1[3])));
  mx = fmaxf(mx, __shfl_xor(mx, 16)); mx = fmaxf(mx, __shfl_xor(mx, 32));
  const float mn = fmaxf(st.m, mx), alpha = ex2(st.m - mn);
  st.m = mn;
  f32x4 p0, p1; float ls = 0.f;
  _Pragma("unroll") for (int j = 0; j < 4; ++j) { p0[j] = ex2(s0[j] - mn); p1[j] = ex2(s1[j] - mn); ls += p0[j] + p1[j]; }
  st.l = st.l * alpha + ls;
  union { bf16x8 v; uint2 h[2]; } pf; pf.h[0] = pack4(p0); pf.h[1] = pack4(p1);
  _Pragma("unroll") for (int dt = 0; dt < 4; ++dt) {
    union { bf16x8 v; uint2 h[2]; } vf;
    vf.h[0] = *(const uint2*)(vB + dt * 16 * PV + voff); vf.h[1] = *(const uint2*)(vB + dt * 16 * PV + voff + 32);
    st.o[dt] *= alpha;
    st.o[dt] = mfma16(vf.v, pf.v, st.o[dt]);
  }
}

DI void attn_block(PPtr p, char* lds, int layer, int type, int b, int h, int idx, u16* o) {
  const int tid = TID(), wave = tid >> 6, lane = tid & 63, fr = lane & 15, quad = lane >> 4;
  const bool isA = (type == 0 || type == 2);
  const int kvh = h / 3, ldk = isA ? 384 : 128;
  const u16* Kall = isA ? p->ak + h * 64 : p->bk + kvh * 64;
  const u16* Kc = Kall + (size_t)(NLAT + b * CTXL) * ldk;
  const u16* Vc = isA ? p->avTc + (size_t)((b * 6 + h) * 64) * CTXL : p->bvTc + (size_t)((b * 2 + kvh) * 64) * CTXL;
  const u16* Vl = isA ? p->avT + (size_t)((b * 6 + h) * 64) * SEQ : p->bvT + (size_t)((b * 2 + kvh) * 64) * SEQ;
  int row;
  if (type == 0) row = b * SEQ + (idx * 2 + (wave >> 2)) * 64 + (wave & 3) * 16 + fr;
  else if (type == 1) row = b * SEQ + idx * 128 + wave * 16 + fr;
  else row = NLAT + b * CTXL + (idx * 8 + wave) * 16 + fr;
  const u16* qp = (isA ? p->aq : p->bq) + (size_t)row * 384 + h * 64 + quad * 8;
  const bf16x8 q0 = *(const bf16x8*)qp, q1 = *(const bf16x8*)(qp + 32);
  AttnSt st; for (int d = 0; d < 4; ++d) st.o[d] = f32x4{0.f, 0.f, 0.f, 0.f}; st.m = -1e30f; st.l = 0.f;
  __syncthreads();
  if (type == 0) {
    const int r0 = idx * 2, r = r0 + (wave >> 2), jb = wave & 3;
    const int kb = min(min(max(r0 - 4, 0), 56), 55);
    attn_fill<576>(lds, Kall + (size_t)(b * SEQ + kb * 64) * ldk, ldk, Vl + kb * 64, SEQ, tid);
    float* rpb = (float*)(lds + ATT_LDS + 64);
    if (tid < 15 * 31) rpb[tid] = p->na_rpb[((size_t)layer * 6 + h) * (15 * 31) + tid] * LOG2E;
    __syncthreads();
    const int rs = min(max(r - 4, 0), 56), kst = min(max(jb * 16 - 8, 0), 32), qc = jb * 16 + fr, ws = min(max(qc - 8, 0), 48);
    const int kbase0 = (rs - kb) * 64 + kst;
    const char* kA = lds + (kbase0 + fr) * 128 + ((quad ^ (fr & 7)) << 4);
    const char* kB = lds + (kbase0 + fr) * 128 + (((4 + quad) ^ (fr & 7)) << 4);
    const char* vB = lds + ATT_K_BYTES + fr * (576 * 2 + 16) + quad * 8 + kbase0 * 2;
    const float* rb0 = rpb + (rs - r + 7) * 31;
    bool va[4], vb[4]; const float* ba[4]; const float* bb[4];
    _Pragma("unroll") for (int j = 0; j < 4; ++j) {
      const int kc0 = kst + quad * 4 + j, kc1 = kc0 + 16;
      va[j] = (kc0 >= ws) && (kc0 < ws + 16); vb[j] = (kc1 >= ws) && (kc1 < ws + 16);
      ba[j] = rb0 + min(max(kc0 - qc + 15, 0), 30); bb[j] = rb0 + min(max(kc1 - qc + 15, 0), 30);
    }
    _Pragma("unroll") for (int i = 0; i < 8; ++i) {
      f32x4 s0, s1;
      lds_qk2(kA, kB, i * 8192, q0, q1, s0, s1);
      _Pragma("unroll") for (int j = 0; j < 4; ++j) {
        s0[j] = va[j] ? s0[j] + ba[j][i * 31] : -1e30f;
        s1[j] = vb[j] ? s1[j] + bb[j][i * 31] : -1e30f;
      }
      lds_pv2<576 * 2 + 16>(st, s0, s1, vB, i * 128);
    }
    __syncthreads();
  } else if (type == 1) {
    const int p0 = idx * 128, kb = min(max(p0 - 128, 0), SEQ - 384);
    attn_fill<384>(lds, Kall + (size_t)(b * SEQ + kb) * ldk, ldk, Vl + kb, SEQ, tid);
    __syncthreads();
    const int q0pos = p0 + wave * 16, qpos = q0pos + fr;
#pragma unroll 1
    for (int i = 0; i < 9; ++i) {
      const int ks = q0pos - 128 + i * 32;
      if (ks + 32 <= 0 || ks >= SEQ) continue;
      const int kl = ks - kb;
      f32x4 s0, s1;
      lds_qk(lds, min(max(kl + fr, 0), 383), min(max(kl + 16 + fr, 0), 383), quad, q0, q1, s0, s1);
      _Pragma("unroll") for (int j = 0; j < 4; ++j) {
        const int k0 = ks + quad * 4 + j, k1 = k0 + 16, d0 = k0 - qpos, d1 = k1 - qpos;
        s0[j] = ((d0 >= -128) && (d0 <= 128) && (k0 >= 0) && (k0 < SEQ)) ? s0[j] : -1e30f;
        s1[j] = ((d1 >= -128) && (d1 <= 128) && (k1 >= 0) && (k1 < SEQ)) ? s1[j] : -1e30f;
      }
      lds_pv(st, s0, s1, lds, 384 * 2 + 16, fr, min(max(kl + quad * 4, 0), 380), min(max(kl + 16 + quad * 4, 0), 380));
    }
    __syncthreads();
  }
  attn_fill<256>(lds, Kc, ldk, Vc, CTXL, tid);
  __syncthreads();
  { const char* kA = lds + fr * 128 + ((quad ^ (fr & 7)) << 4);
    const char* kB = lds + fr * 128 + (((4 + quad) ^ (fr & 7)) << 4);
    const char* vB = lds + ATT_K_BYTES + fr * (256 * 2 + 16) + quad * 8;
    _Pragma("unroll") for (int i = 0; i < 8; ++i) {
      f32x4 s0, s1;
      lds_qk2(kA, kB, i * 4096, q0, q1, s0, s1);
      lds_pv2<256 * 2 + 16>(st, s0, s1, vB, i * 64);
    } }
  float l = st.l; l += __shfl_xor(l, 16); l += __shfl_xor(l, 32);
  if (!isA) l += ex2(p->swa_sink[layer * 6 + h] * LOG2E - st.m);
  const float inv = 1.f / l;
  u16* orow = o + (size_t)row * D + (isA ? 0 : 384) + h * 64;
  _Pragma("unroll") for (int dt = 0; dt < 4; ++dt) *(uint2*)(orow + dt * 16 + quad * 4) = pack4(st.o[dt] * inv);
}

struct LFr { bf16x8 k00, k01, k10, k11; uint2 v[8]; };
DI void lds_load(LFr& f, const char* lds, int pv, int fr, int quad, int kk0, int kk1, int kv0, int kv1) {
  const char* r0 = lds + kk0 * 128; const char* r1 = lds + kk1 * 128;
  f.k00 = *(const bf16x8*)(r0 + ((quad ^ (kk0 & 7)) << 4)); f.k01 = *(const bf16x8*)(r0 + (((4 + quad) ^ (kk0 & 7)) << 4));
  f.k10 = *(const bf16x8*)(r1 + ((quad ^ (kk1 & 7)) << 4)); f.k11 = *(const bf16x8*)(r1 + (((4 + quad) ^ (kk1 & 7)) << 4));
  const char* vb = lds + ATT_K_BYTES + fr * pv;
  _Pragma("unroll") for (int dt = 0; dt < 4; ++dt) { f.v[dt * 2] = *(const uint2*)(vb + dt * 16 * pv + kv0 * 2); f.v[dt * 2 + 1] = *(const uint2*)(vb + dt * 16 * pv + kv1 * 2); }
}
DI void frag_qk(const LFr& f, bf16x8 q0, bf16x8 q1, f32x4& s0, f32x4& s1) {
  const f32x4 z = {0.f, 0.f, 0.f, 0.f};
  s0 = mfma16(f.k00, q0, z); s0 = mfma16(f.k01, q1, s0);
  s1 = mfma16(f.k10, q0, z); s1 = mfma16(f.k11, q1, s1);
}
DI void frag_pv(AttnSt& st, f32x4 s0, f32x4 s1, const LFr& f) {
  float mx = fmaxf(fmaxf(fmaxf(s0[0], s0[1]), fmaxf(s0[2], s0[3])), fmaxf(fmaxf(s1[0], s1[1]), fmaxf(s1[2], s1[3])));
  mx = fmaxf(mx, __shfl_xor(mx, 16)); mx = fmaxf(mx, __shfl_xor(mx, 32));
  const float mn = fmaxf(st.m, mx), alpha = ex2(st.m - mn);
  st.m = mn;
  f32x4 p0, p1; float ls = 0.f;
  _Pragma("unroll") for (int j = 0; j < 4; ++j) { p0[j] = ex2(s0[j] - mn); p1[j] = ex2(s1[j] - mn); ls += p0[j] + p1[j]; }
  st.l = st.l * alpha + ls;
  union { bf16x8 v; uint2 h[2]; } pf; pf.h[0] = pack4(p0); pf.h[1] = pack4(p1);
  _Pragma("unroll") for (int dt = 0; dt < 4; ++dt) {
    union { bf16x8 v; uint2 h[2]; } vf; vf.h[0] = f.v[dt * 2]; vf.h[1] = f.v[dt * 2 + 1];
    st.o[dt] *= alpha;
    st.o[dt] = mfma16(vf.v, pf.v, st.o[dt]);
  }
}

DI void attn_block_swa3(PPtr p, char* lds, int layer, int b, int kvh, int idx, u16* o) {
  const int tid = TID(), wave = tid >> 6, lane = tid & 63, fr = lane & 15, quad = lane >> 4;
  const int ldk = 128;
  const u16* Kall = p->bk + kvh * 64;
  const u16* Kc = Kall + (size_t)(NLAT + b * CTXL) * ldk;
  const u16* Vc = p->bvTc + (size_t)((b * 2 + kvh) * 64) * CTXL;
  const u16* Vl = p->bvT + (size_t)((b * 2 + kvh) * 64) * SEQ;
  const int p0 = idx * 128, q0pos = p0 + wave * 16, qpos = q0pos + fr, row = b * SEQ + qpos;
  bf16x8 q0[3], q1[3]; AttnSt st[3];
  _Pragma("unroll") for (int hh = 0; hh < 3; ++hh) {
    const u16* qp = p->bq + (size_t)row * 384 + (kvh * 3 + hh) * 64 + quad * 8;
    q0[hh] = *(const bf16x8*)qp; q1[hh] = *(const bf16x8*)(qp + 32);
    for (int d = 0; d < 4; ++d) st[hh].o[d] = f32x4{0.f, 0.f, 0.f, 0.f}; st[hh].m = -1e30f; st[hh].l = 0.f;
  }
  __syncthreads();
  const int kb = min(max(p0 - 128, 0), SEQ - 384);
  attn_fill<384>(lds, Kall + (size_t)(b * SEQ + kb) * ldk, ldk, Vl + kb, SEQ, tid);
  __syncthreads();
#pragma unroll 1
  for (int i = 0; i < 9; ++i) {
    const int ks = q0pos - 128 + i * 32;
    if (ks + 32 <= 0 || ks >= SEQ) continue;
    const int kl = ks - kb;
    LFr f;
    lds_load(f, lds, 384 * 2 + 16, fr, quad, min(max(kl + fr, 0), 383), min(max(kl + 16 + fr, 0), 383),
             min(max(kl + quad * 4, 0), 380), min(max(kl + 16 + quad * 4, 0), 380));
    bool v0[4], v1[4];
    _Pragma("unroll") for (int j = 0; j < 4; ++j) {
      const int k0 = ks + quad * 4 + j, k1 = k0 + 16, d0 = k0 - qpos, d1 = k1 - qpos;
      v0[j] = (d0 >= -128) && (d0 <= 128) && (k0 >= 0) && (k0 < SEQ); v1[j] = (d1 >= -128) && (d1 <= 128) && (k1 >= 0) && (k1 < SEQ);
    }
    _Pragma("unroll") for (int hh = 0; hh < 3; ++hh) {
      f32x4 s0, s1;
      frag_qk(f, q0[hh], q1[hh], s0, s1);
      _Pragma("unroll") for (int j = 0; j < 4; ++j) { s0[j] = v0[j] ? s0[j] : -1e30f; s1[j] = v1[j] ? s1[j] : -1e30f; }
      frag_pv(st[hh], s0, s1, f);
    }
  }
  __syncthreads();
  attn_fill<256>(lds, Kc, ldk, Vc, CTXL, tid);
  __syncthreads();
#pragma unroll 1
  for (int i = 0; i < 8; ++i) {
    LFr f;
    lds_load(f, lds, 256 * 2 + 16, fr, quad, i * 32 + fr, i * 32 + 16 + fr, i * 32 + quad * 4, i * 32 + 16 + quad * 4);
    _Pragma("unroll") for (int hh = 0; hh < 3; ++hh) { f32x4 s0, s1; frag_qk(f, q0[hh], q1[hh], s0, s1); frag_pv(st[hh], s0, s1, f); }
  }
  _Pragma("unroll") for (int hh = 0; hh < 3; ++hh) {
    const int hq = kvh * 3 + hh;
    float l = st[hh].l; l += __shfl_xor(l, 16); l += __shfl_xor(l, 32);
    l += ex2(p->swa_sink[layer * 6 + hq] * LOG2E - st[hh].m);
    const float inv = 1.f / l;
    u16* orow = o + (size_t)row * D + 384 + hq * 64;
    _Pragma("unroll") for (int dt = 0; dt < 4; ++dt) *(uint2*)(orow + dt * 16 + quad * 4) = pack4(st[hh].o[dt] * inv);
  }
}

DI void phase_mixer(PPtr p, char* shmc, int layer, int rep) {
  volatile int* s_item = (volatile int*)(shmc + ATT_LDS);
  u16* o = p->hn;
  const bool ctx_out = (layer == 0);
  const int nNA = 1536, nSWA = 512, nC = ctx_out ? 192 : 0;
  const int total = nNA + nSWA + nC;
  const int tid = TID();
  for (;;) {
    __syncthreads();
    if (tid == 0) *s_item = (int)atomicAdd(p->ctr + layer + 2 * rep, 1u);
    __syncthreads();
    const int it = __builtin_amdgcn_readfirstlane(*s_item);
    if (it >= total) break;
    int type, b, h, idx;
    if (it < nNA) { type = 0; int bh = it >> 5; idx = it & 31; b = bh / 6; h = bh % 6; }
    else if (it < nNA + nSWA) { type = 1; int id = it - nNA; int bkv = id >> 5; idx = id & 31; b = bkv >> 1; h = bkv & 1; }
    else { int id = it - nNA - nSWA; type = 2 + id / 96; int r2 = id % 96; int bh = r2 >> 1; idx = r2 & 1; b = bh / 6; h = bh % 6; }
    if (type == 1) attn_block_swa3(p, shmc, layer, b, h, idx, o); else attn_block(p, shmc, layer, type, b, h, idx, o);
  }
}

DI void phase_fnet_combine(PPtr p, int first) {
  if ((int)blockIdx.x < first) return;
  const int tid = TID(); const int gt = ((int)blockIdx.x - first) * NTHREADS + tid, nthr = ((int)gridDim.x - first) * NTHREADS;
  u16* o = p->hn;
#pragma unroll 1
  for (int id = gt; id < NB * 2048 * 32; id += nthr) {
    const int c8 = (id & 31) * 8, k = (id >> 5) & 2047, b = id >> 16;
    const uint4 e = *(const uint4*)(p->eo + ((size_t)b * 2048 + k) * 256 + c8);
    const uint4 q = *(const uint4*)(p->eo + ((size_t)(NB + b) * 2048 + k) * 256 + c8);
    const unsigned ew[4] = {e.x, e.y, e.z, e.w}, qw[4] = {q.x, q.y, q.z, q.w}; unsigned f1[4], f2[4];
    _Pragma("unroll") for (int i = 0; i < 4; ++i) {
      const float el = __uint_as_float(ew[i] << 16), eh = __uint_as_float(ew[i] & 0xffff0000u), ql = __uint_as_float(qw[i] << 16), qh = __uint_as_float(qw[i] & 0xffff0000u);
      f1[i] = pack2(el - ql, eh - qh); f2[i] = pack2(el + ql, eh + qh);
    }
    uint4 v1; v1.x = f1[0]; v1.y = f1[1]; v1.z = f1[2]; v1.w = f1[3];
    *(uint4*)(o + ((size_t)b * SEQ + k) * D + 768 + c8) = v1;
    if (k > 0) { uint4 v2; v2.x = f2[0]; v2.y = f2[1]; v2.z = f2[2]; v2.w = f2[3]; *(uint4*)(o + ((size_t)b * SEQ + (SEQ - k)) * D + 768 + c8) = v2; }
  }
  const int gw = gt >> 6, lane = tid & 63;
#pragma unroll 1
  for (int id = gw; id < NB * 256; id += (nthr >> 6)) {
    const int b = id >> 8, ch = id & 255;
    const u16* pr = p->pqT + ((size_t)b * 256 + ch) * SEQ;
    float sacc = 0.f;
    _Pragma("unroll") for (int i = 0; i < 8; ++i) {
      const uint4 v = *(const uint4*)(pr + (i * 64 + lane) * 8);
      const unsigned vw[4] = {v.x, v.y, v.z, v.w};
      _Pragma("unroll") for (int j = 0; j < 4; ++j) sacc += __uint_as_float(vw[j] << 16) - __uint_as_float(vw[j] & 0xffff0000u);
    }
    sacc = wave_sum(sacc);
    if (lane == 0) o[((size_t)b * SEQ + 2048) * D + 768 + ch] = f2bf(sacc * (1.f / 512.f));
  }
}

#define XB_TMO      128
#define XB_XCNT(j)  (256  + 64 * (j))
#define XB_XSUB(j)  (1280 + 64 * (j))
#define XB_XGEN(j)  (2304 + 64 * (j))
#define XB_TOP      3328
#define XB_TOPGEN   3392
#define XCD_BAR_WORDS 3456
#define XB_SPIN_CAP (1u << 18)
#define LAS __attribute__((address_space(3)))
DI unsigned xb_ld(unsigned* p)              { return __hip_atomic_load(p, __ATOMIC_RELAXED, __HIP_MEMORY_SCOPE_AGENT); }
DI unsigned xb_add(unsigned* p, unsigned v) { return __hip_atomic_fetch_add(p, v, __ATOMIC_RELAXED, __HIP_MEMORY_SCOPE_AGENT); }
DI unsigned xb_xcc_id() { return (unsigned)__builtin_amdgcn_s_getreg((3 << 11) | 20) & 0xFu; }
#define XB_SPIN(cond, bar) do { unsigned _sp = 0; while (cond) { __builtin_amdgcn_s_sleep(1); \
    if ((++_sp & 255u) == 0u) { if (xb_ld(&(bar)[XB_TMO])) break; if (_sp > XB_SPIN_CAP) { atomicAdd(&(bar)[XB_TMO], 1u); break; } } } } while (0)
struct XcdBarrier { unsigned* bar; unsigned x; volatile LAS unsigned* st; };
DI XcdBarrier xcd_barrier_post(unsigned* bar, volatile LAS unsigned* st) {
    XcdBarrier b; b.bar = bar; b.x = xb_xcc_id(); b.st = st;
    if (threadIdx.x == 0) (void)xb_add(&bar[XB_XCNT(b.x)], 1u);
    return b;
}
DI void xcd_barrier_complete(unsigned* bar, unsigned x, unsigned& nloc, unsigned& nx) {
    const unsigned G = gridDim.x * gridDim.y * gridDim.z;
    unsigned sum, cnt, mine, sp = 0u;
    for (;;) {
        sum = 0u; cnt = 0u; mine = 0u;
#pragma unroll
        for (unsigned j = 0; j < 16; ++j) { const unsigned c = xb_ld(&bar[XB_XCNT(j)]); sum += c; cnt += (c > 0u) ? 1u : 0u; mine = (j == x) ? c : mine; }
        if (sum == G) break;
        __builtin_amdgcn_s_sleep(1);
        if ((++sp & 255u) == 0u) { if (xb_ld(&bar[XB_TMO])) break; if (sp > XB_SPIN_CAP) { atomicAdd(&bar[XB_TMO], 1u); break; } }
    }
    nloc = mine > 0u ? mine : 1u; nx = cnt > 0u ? cnt : 1u;
}
DI void xcd_barrier(const XcdBarrier& b) {
    asm volatile("s_waitcnt vmcnt(0)" ::: "memory");
    __syncthreads();
    if (threadIdx.x == 0) {
        unsigned* bar = b.bar;
        __builtin_amdgcn_s_waitcnt(0);
        unsigned nloc = b.st[0], nx = b.st[1];
        if (nloc == 0u) { xcd_barrier_complete(bar, b.x, nloc, nx); b.st[0] = nloc; b.st[1] = nx; }
        const unsigned old = xb_add(&bar[XB_XSUB(b.x)], 1u);
        const unsigned gen = old / nloc;
        if (old + 1u == (gen + 1u) * nloc) {
            __builtin_amdgcn_fence(__ATOMIC_RELEASE, "agent");
            asm volatile("s_waitcnt vmcnt(0)" ::: "memory");
            const unsigned og = xb_add(&bar[XB_TOP], 1u);
            const unsigned tg = og / nx;
            if (og + 1u == (tg + 1u) * nx) xb_add(&bar[XB_TOPGEN], 1u);
            else XB_SPIN(xb_ld(&bar[XB_TOPGEN]) == tg, bar);
            __builtin_amdgcn_fence(__ATOMIC_ACQUIRE, "agent");
            xb_add(&bar[XB_XGEN(b.x)], 1u);
            asm volatile("s_waitcnt vmcnt(0)" ::: "memory");
        } else {
            XB_SPIN(xb_ld(&bar[XB_XGEN(b.x)]) == gen, bar);
            __builtin_amdgcn_fence(__ATOMIC_ACQUIRE, "agent");
            asm volatile("s_waitcnt vmcnt(0)" ::: "memory");
        }
    }
    __syncthreads();
}

constexpr int N_PHASES = 2 + 2 * 10;

__global__ void __launch_bounds__(NTHREADS) mega_kernel(Params p_arg, int ph_lo, int ph_hi) {
  extern __shared__ __attribute__((aligned(16))) char shmc[];
  u16* shm = (u16*)shmc;
  PPtr p = (PPtr)__builtin_amdgcn_kernarg_segment_ptr();
  volatile LAS unsigned* xst = (volatile LAS unsigned*)(shmc + XB_ST_OFF);
  if (threadIdx.x == 0) { xst[0] = 0u; xst[1] = 0u; }
  __syncthreads();
  const XcdBarrier xb = xcd_barrier_post(p->bar, xst);
#pragma unroll 1
  for (int ph = ph_lo; ph < ph_hi; ++ph) {
    p = pp_fresh(p);
    const int l = (ph >= 2) ? (ph - 2) / 10 : 0, s = (ph >= 2) ? (ph - 2) % 10 : -1;
    const int Mfull = R, Mlate = (l == 0) ? R : NLAT;
    const bool split5 = (s == 5 && l == 0 && gridDim.x > 64);
#pragma unroll 1
    for (int rep = 0; rep < ((ph == PROBE_REP_PH || split5) ? 2 : 1); ++rep) {
    GemmDesc g{}; g.ntiles = 0;
    if (s == 0)      g = GemmDesc{p->hn, p->w1t + (size_t)(l * 2 + 0) * 2 * DFF * D, p->h,  Mfull, 2 * DFF, D,    1, 0, 3, 0, p->w2t + (size_t)(l * 2 + 0) * D * DFF, p->ctr + 8 + l * 2};
    else if (s == 1) g = GemmDesc{p->h,  p->w2t + (size_t)(l * 2 + 0) * D * DFF,     p->y,  NLAT,  D,       DFF,  0, D, 0, 0};
    else if (s == 3) g = GemmDesc{p->hn, p->wint + (size_t)l * DINX * D,             nullptr, Mfull, DINX,  D,    2, 0, 2, 0};
    else if (s == 4) g = GemmDesc{p->dft, p->pqT,                                    p->hn, 0,     0,       4096, 0, D, 1, 0};
    else if (s == 5) {
      if (split5 && rep == 0) g = GemmDesc{p->hn + (size_t)NLAT * D, p->woutt + (size_t)l * D * D, p->y + (size_t)NLAT * D, NCTX, D, D, 0, D, 0, 0};
      else                    g = GemmDesc{p->hn, p->woutt + (size_t)l * D * D, p->y, split5 ? NLAT : Mlate, D, D, 0, D, 0, 0};
    }
    else if (s == 7) g = GemmDesc{p->hn, p->w1t + (size_t)(l * 2 + 1) * 2 * DFF * D, p->h,  Mlate, 2 * DFF, D,    1, 0, (l == 0) ? 3 : 0, 0, p->w2t + (size_t)(l * 2 + 1) * D * DFF, p->ctr + 8 + l * 2 + 1};
    else if (s == 8) g = GemmDesc{p->h,  p->w2t + (size_t)(l * 2 + 1) * D * DFF,     p->y,  NLAT,  D,       DFF,  0, D, 0, 0};
    if (s == 5 && !split5) { phase_fnet_combine(p, 0); xcd_barrier(xb); }
    g.ntiles = (g.mode == 1) ? (128 + (l == 0 ? 8 : 0)) : (g.mode == 3) ? (R / BM) * (2 * DFF / BM) + (NCTX / BM) * (D / BM) : (g.M / BM) * (g.N / BM);
    if (g.ntiles > 0) gemm_run(shm, p, g);
    if (split5 && rep == 0) { phase_fnet_combine(p, 32); xcd_barrier(xb); }
    if (ph == 0) phase_prep(p, shmc);
    else if (ph == 1 || s == 2 || s == 6 || s == 9) {
      int M = Mlate, lp = l, sp = -1, ln = l, sn = -1; bool first = false;
      if (ph == 1) { M = R; sn = 0; first = true; }
      else if (s == 2) { M = Mfull; sp = 0; sn = 1; first = (l == 0); }
      else if (s == 6) { sp = 1; sn = 2; }
      else { sp = 2; ln = l + 1; sn = (l == 0) ? 0 : -1; }
      phase_norm(p, M, lp, sp, ln, sn, first);
    } else if (s == 4) phase_mixer(p, shmc, l, rep);
    }
    if (ph + 1 < ph_hi) {
      if (ph_hi > 1000) cg::this_grid().sync();
      xcd_barrier(xb);
    }
  }
}

extern "C" void kernel_launch(void* const* d_in, const int* in_sizes, int n_in, void* d_out, int out_size, void* d_ws, size_t ws_size,
                              hipStream_t stream) {
  Params p{};
  p.x = (const float*)d_in[0]; p.c = (const float*)d_in[1]; p.ctx = (const float*)d_in[2]; p.c_ctx = (const float*)d_in[3];
  p.w_mod = (const float*)d_in[4]; p.b_mod = (const float*)d_in[5]; p.g_pre = (const float*)d_in[6]; p.g_post = (const float*)d_in[7];
  p.w_ffn_in = (const float*)d_in[8]; p.w_ffn_out = (const float*)d_in[9]; p.w_in = (const float*)d_in[10]; p.w_out = (const float*)d_in[11];
  p.na_rpb = (const float*)d_in[12]; p.swa_sink = (const float*)d_in[13];
  p.out = (float*)d_out;
  char* w = (char*)d_ws; size_t off = 0;
  auto take = [&](size_t bytes) { char* r = w + off; off += (bytes + 255) & ~(size_t)255; return r; };
  p.ctr = (unsigned*)take(256);
  p.bar = (unsigned*)take(XCD_BAR_WORDS * 4);
  p.mod = (float*)take((size_t)2 * 9 * NMOD * D * 4);
  p.xc = (float*)take((size_t)NCTX * D * 4);
  p.w1t = (u16*)take((size_t)4 * 2 * DFF * D * 2);
  p.w2t = (u16*)take((size_t)4 * D * DFF * 2);
  p.wint = (u16*)take((size_t)2 * DINX * D * 2);
  p.woutt = (u16*)take((size_t)2 * D * D * 2);
  p.dft = (u16*)take((size_t)2 * 2048 * 4096 * 2);
  p.eo = (u16*)take((size_t)2 * NB * 2048 * 256 * 2);
  p.dftc = (u16*)take((size_t)256 * 512 * 2);
  p.hn = (u16*)take((size_t)R * D * 2);
  p.y = (u16*)take((size_t)R * D * 2);
  p.h = (u16*)take((size_t)R * DFF * 2);
  { char* q = (char*)p.h; size_t o2 = 0; auto tk = [&](size_t bytes) { char* r = q + o2; o2 += (bytes + 255) & ~(size_t)255; return (u16*)r; };
    p.aq = tk((size_t)R * 384 * 2); p.ak = tk((size_t)R * 384 * 2); p.bq = tk((size_t)R * 384 * 2); p.bk = tk((size_t)R * 128 * 2);
    p.avT = tk((size_t)NB * 6 * 64 * SEQ * 2); p.avTc = tk((size_t)NB * 6 * 64 * CTXL * 2);
    p.bvT = tk((size_t)NB * 2 * 64 * SEQ * 2); p.bvTc = tk((size_t)NB * 2 * 64 * CTXL * 2);
    p.pqT = tk((size_t)NB * 256 * 2 * SEQ * 2); p.pqTc = tk((size_t)NB * 256 * 2 * CTXL * 2);
    if (o2 > (size_t)R * DFF * 2) { fprintf(stderr, "alias overflow\n"); return; } }
  if (off > ws_size) { fprintf(stderr, "workspace too small: need %zu have %zu\n", off, ws_size); return; }

  (void)hipMemsetAsync(p.bar, 0, XCD_BAR_WORDS * 4, stream);
  static int grid_blocks = 0;
  if (!grid_blocks) {
    int dev = 0, cus = 0, per_cu = 0;
    (void)hipGetDevice(&dev);
    (void)hipDeviceGetAttribute(&cus, hipDeviceAttributeMultiprocessorCount, dev);
    (void)hipFuncSetAttribute((const void*)mega_kernel, hipFuncAttributeMaxDynamicSharedMemorySize, LDS_BYTES);
    (void)hipOccupancyMaxActiveBlocksPerMultiprocessor(&per_cu, (const void*)mega_kernel, NTHREADS, LDS_BYTES);
    if (per_cu < 1) fprintf(stderr, "occupancy query says %d blocks/CU\n", per_cu);
    grid_blocks = cus > 0 ? cus : 256;
  }
#if MK_MULTI
  for (int ph = 0; ph < N_PHASES; ++ph)
    hipLaunchKernelGGL(mega_kernel, dim3(grid_blocks), dim3(NTHREADS), LDS_BYTES, stream, p, ph, ph + 1);
#else
  int ph_lo = 0, ph_hi = N_PHASES;
  void* args[] = {&p, &ph_lo, &ph_hi};
  hipError_t e = hipLaunchCooperativeKernel((const void*)mega_kernel, dim3(grid_blocks), dim3(NTHREADS), args, LDS_BYTES, stream);
  if (e != hipSuccess) fprintf(stderr, "cooperative launch failed: %s (grid %d)\n", hipGetErrorString(e), grid_blocks);
#endif
}
```
